# Optimizing an MI355X kernel written in HIP

```python
import math
import jax
import jax.numpy as jnp
from jax import lax
import numpy as np


D_MODEL = 2048
BATCH = 1
SEQ = 8192
DEPTH = 4

GRID_W = 64
CTX_LEN = 256
D_MIX = D_MODEL
NORM_EPS = 1e-6

D_A = D_MIX // 4
A_HEADS = 4
A_HEAD_DIM = D_A // A_HEADS
A_CHUNK = 128

D_B = D_MIX // 4
B_HEADS = 4
B_KEY_DIM = D_B // B_HEADS
B_VAL_DIM = D_B // B_HEADS
B_CHUNK = 64

D_C = D_MIX // 2
C_HEADS = 4
C_HEAD_DIM = D_C // C_HEADS // 2
C_VAL_DIM = 2 * C_HEAD_DIM
Q_BLOCK = 128
ROPE_THETA = 10000.0
ROPE_AXIS_DIM = C_HEAD_DIM // 2

D_IN = 3 * D_A + 5 * D_B + 4 * D_C

kernel_name = 'hybrid_gmlp_hgrn2_diffattn_dit_trunk'


def rms_norm(x, w):
    xf = x.astype(jnp.float32)
    y = xf * lax.rsqrt(jnp.mean(xf * xf, axis=-1, keepdims=True) + NORM_EPS)
    return (y * w.astype(jnp.float32)).astype(x.dtype)


def layer_norm(x, w, b):
    xf = x.astype(jnp.float32)
    mu = jnp.mean(xf, axis=-1, keepdims=True)
    xc = xf - mu
    var = jnp.mean(xc * xc, axis=-1, keepdims=True)
    return (xc * lax.rsqrt(var + NORM_EPS) * w.astype(jnp.float32) + b.astype(jnp.float32)).astype(x.dtype)


def split_columns(p):
    sizes = (D_A, D_A, D_A, D_B, D_B, D_B, D_B, D_B, D_C, D_C, D_C, D_C)
    idx = np.cumsum(sizes)[:-1].tolist()
    return jnp.split(p, idx, axis=-1)


def axial_rope_tables(seq):
    rows = seq // GRID_W
    row_ids = jnp.repeat(jnp.arange(rows, dtype=jnp.float32), GRID_W)
    col_ids = jnp.tile(jnp.arange(GRID_W, dtype=jnp.float32), rows)
    inv = ROPE_THETA ** (-jnp.arange(0, ROPE_AXIS_DIM, 2, dtype=jnp.float32) / ROPE_AXIS_DIM)
    ang_r = row_ids[:, None] * inv[None, :]
    ang_c = col_ids[:, None] * inv[None, :]
    return (jnp.cos(ang_r), jnp.sin(ang_r), jnp.cos(ang_c), jnp.sin(ang_c))


def rope_rotate(x, cos, sin):
    x1, x2 = jnp.split(x.astype(jnp.float32), 2, axis=-1)
    cos = cos[:, None, None, :]
    sin = sin[:, None, None, :]
    return jnp.concatenate([x1 * cos - x2 * sin, x2 * cos + x1 * sin], axis=-1)


def rope_2d(x, tabs):
    cos_r, sin_r, cos_c, sin_c = tabs
    x_row, x_col = jnp.split(x, 2, axis=-1)
    y = jnp.concatenate([rope_rotate(x_row, cos_r, sin_r), rope_rotate(x_col, cos_c, sin_c)], axis=-1)
    return y.astype(x.dtype)


def gmlp_branch(u, v, z, ln_w, ln_b, ws, bs):
    bsz, t, _ = v.shape
    u = jax.nn.gelu(u, approximate=False)
    v = layer_norm(jax.nn.gelu(v, approximate=False), ln_w, ln_b)
    vr = v.reshape(bsz, t // A_CHUNK, A_CHUNK, A_HEADS, A_HEAD_DIM)
    s = jnp.einsum('hts,bnshd->bnthd', ws, vr) + bs.T[None, None, :, :, None]
    s = s.reshape(bsz, t, D_A)
    return u * s * jax.nn.silu(z)


def hgrn_heads(a):
    bsz, t, _ = a.shape
    return a.reshape(bsz, t, B_HEADS, a.shape[-1] // B_HEADS)


def hgrn_gates(a, lb):
    af = a.astype(jnp.float32)
    logf = jnp.logaddexp(jnp.log(lb), jnp.log1p(-lb) + jax.nn.log_sigmoid(af))
    k = (1.0 - lb) * jax.nn.sigmoid(-af)
    return hgrn_heads(k), hgrn_heads(logf)


def hgrn2_chunk_scan(q, k, v, logf, state0):
    bsz, t, h, _ = q.shape
    dv = v.shape[-1]
    n = t // B_CHUNK

    def to_chunks(a):
        return a.astype(jnp.float32).reshape(bsz, n, B_CHUNK, h, a.shape[-1]).transpose(1, 0, 2, 3, 4)

    lower = jnp.tril(jnp.ones((B_CHUNK, B_CHUNK), dtype=bool))[None, :, :, None, None]

    def step(state, inp):
        qc, kc, vc, gc = inp
        b = jnp.cumsum(gc, axis=1)
        o_inter = jnp.einsum('bthk,bhkv->bthv', qc * jnp.exp(b), state)
        decay = jnp.exp(jnp.where(lower, b[:, :, None] - b[:, None, :], -jnp.inf))
        scores = jnp.einsum('bthk,bshk,btshk->bths', qc, kc, decay)
        o_intra = jnp.einsum('bths,bshv->bthv', scores, vc)
        b_last = b[:, -1]
        k_dec = kc * jnp.exp(b_last[:, None] - b)
        new_state = jnp.exp(b_last)[..., None] * state + jnp.einsum('bshk,bshv->bhkv', k_dec, vc)
        return new_state, o_inter + o_intra

    final, out = lax.scan(step, state0, (to_chunks(q), to_chunks(k), to_chunks(v), to_chunks(logf)))
    out = out.transpose(1, 0, 2, 3, 4).reshape(bsz, t, h, dv)
    return final, out


def hgrn_output(o, z, norm_w):
    bsz, t = o.shape[0], o.shape[1]
    o = rms_norm(o.astype(z.dtype), norm_w).reshape(bsz, t, D_B)
    return o * jax.nn.silu(z)


def diff_attend(q, k, v, lam):
    s = jnp.einsum('bqhmd,bkhmd->bhmqk', q * (C_HEAD_DIM ** -0.5), k).astype(jnp.float32)
    p = jax.nn.softmax(s, axis=-1)
    w = p[:, :, 0] - lam * p[:, :, 1]
    return jnp.einsum('bhqk,bkhe->bqhe', w.astype(v.dtype), v)


def diff_output(o, z, subln_w, lam_init):
    bsz, t = o.shape[0], o.shape[1]
    o = (rms_norm(o, subln_w) * (1.0 - lam_init)).reshape(bsz, t, D_C)
    return o * jax.nn.silu(z)


def hybrid_layer(x, xc, c, c_ctx, ada_w, ada_b, norm_w, w_in, g_ln_w, g_ln_b, g_ws, g_bs,
                 lb_fwd, lb_bwd, h_norm_w, lam_params, lam_init, subln_w, w_out, rope, ctx_out):
    bsz, t, _ = x.shape
    shift, scale, gate = jnp.split(jax.nn.silu(c) @ ada_w + ada_b, 3, axis=-1)
    shift_c, scale_c, gate_c = jnp.split(jax.nn.silu(c_ctx) @ ada_w + ada_b, 3, axis=-1)
    h = rms_norm(x, norm_w) * (1.0 + scale[:, None]) + shift[:, None]
    hc = rms_norm(xc, norm_w) * (1.0 + scale_c) + shift_c

    (a_u, a_v, a_z, b_q, b_i, b_ff, b_fb, b_z, c_q, c_k, c_v, c_z) = split_columns(h @ w_in)
    (ac_u, ac_v, ac_z, bc_q, bc_i, bc_ff, bc_fb, bc_z, cc_q, cc_k, cc_v, cc_z) = split_columns(hc @ w_in)

    y_a = gmlp_branch(a_u, a_v, a_z, g_ln_w, g_ln_b, g_ws, g_bs)

    qx, vx = hgrn_heads(jax.nn.silu(b_q)), hgrn_heads(b_i)
    kfx, gfx = hgrn_gates(b_ff, lb_fwd)
    kbx, gbx = hgrn_gates(b_fb, lb_bwd)
    qcx, vcx = hgrn_heads(jax.nn.silu(bc_q)), hgrn_heads(bc_i)
    kfc, gfc = hgrn_gates(bc_ff, lb_fwd)
    kbc, gbc = hgrn_gates(bc_fb, lb_bwd)
    flip = lambda a: jnp.flip(a, axis=1)
    s0 = jnp.zeros((bsz, B_HEADS, B_KEY_DIM, B_VAL_DIM), jnp.float32)
    s_fwd, oc_f = hgrn2_chunk_scan(qcx, kfc, vcx, gfc, s0)
    _, ox_f = hgrn2_chunk_scan(qx, kfx, vx, gfx, s_fwd)
    s_bwd, oc_b = hgrn2_chunk_scan(flip(qcx), flip(kbc), flip(vcx), flip(gbc), s0)
    _, ox_b = hgrn2_chunk_scan(flip(qx), flip(kbx), flip(vx), flip(gbx), s_bwd)
    y_b = hgrn_output(ox_f + flip(ox_b), b_z, h_norm_w)

    lp = lam_params.astype(jnp.float32)
    lam = jnp.exp(jnp.sum(lp[0] * lp[1])) - jnp.exp(jnp.sum(lp[2] * lp[3])) + lam_init
    n_ctx = xc.shape[1]
    q_lat = rope_2d(c_q.reshape(bsz, t, C_HEADS, 2, C_HEAD_DIM), rope)
    k_lat = rope_2d(c_k.reshape(bsz, t, C_HEADS, 2, C_HEAD_DIM), rope)
    v_lat = c_v.reshape(bsz, t, C_HEADS, C_VAL_DIM)
    q_ctx = cc_q.reshape(bsz, n_ctx, C_HEADS, 2, C_HEAD_DIM)
    k_ctx = cc_k.reshape(bsz, n_ctx, C_HEADS, 2, C_HEAD_DIM)
    v_ctx = cc_v.reshape(bsz, n_ctx, C_HEADS, C_VAL_DIM)
    keys = jnp.concatenate([k_lat, k_ctx], axis=1)
    vals = jnp.concatenate([v_lat, v_ctx], axis=1)
    nb = t // Q_BLOCK
    q_blocks = q_lat.reshape(bsz, nb, Q_BLOCK, C_HEADS, 2, C_HEAD_DIM).transpose(1, 0, 2, 3, 4, 5)
    o_blocks = lax.map(lambda qb: diff_attend(qb, keys, vals, lam), q_blocks)
    o_lat = o_blocks.transpose(1, 0, 2, 3, 4).reshape(bsz, t, C_HEADS, C_VAL_DIM)
    y_c = diff_output(o_lat, c_z, subln_w, lam_init)

    y = jnp.concatenate([y_a, y_b, y_c], axis=-1) @ w_out
    x_new = x + gate[:, None] * y

    if ctx_out:
        yc_a = gmlp_branch(ac_u, ac_v, ac_z, g_ln_w, g_ln_b, g_ws, g_bs)
        yc_b = hgrn_output(oc_f + flip(oc_b), bc_z, h_norm_w)
        yc_c = diff_output(diff_attend(q_ctx, k_ctx, v_ctx, lam), cc_z, subln_w, lam_init)
        yc = jnp.concatenate([yc_a, yc_b, yc_c], axis=-1) @ w_out
        xc = xc + gate_c * yc
    return x_new, xc


def setup_inputs(seed: int = 0) -> dict:
    key = jax.random.key(seed)
    ks = jax.random.split(key, 20)
    f32 = jnp.float32

    def nrm(k, shape, s):
        return jax.random.normal(k, shape, f32) * s

    return {
        'x': nrm(ks[0], (BATCH, SEQ, D_MODEL), 1.0),
        'c': nrm(ks[1], (BATCH, D_MODEL), 1.0),
        'ctx': nrm(ks[2], (BATCH, CTX_LEN, D_MODEL), 1.0),
        'c_ctx': nrm(ks[3], (D_MODEL,), 1.0),
        'ada_w': nrm(ks[4], (DEPTH, D_MODEL, 3 * D_MODEL), 0.5 * D_MODEL ** -0.5),
        'ada_b': nrm(ks[5], (DEPTH, 3 * D_MODEL), 0.02),
        'norm_w': 1.0 + nrm(ks[6], (DEPTH, D_MODEL), 0.02),
        'w_in': nrm(ks[7], (DEPTH, D_MODEL, D_IN), D_MODEL ** -0.5),
        'gmlp_ln_w': 1.0 + nrm(ks[8], (DEPTH, D_A), 0.02),
        'gmlp_ln_b': nrm(ks[9], (DEPTH, D_A), 0.02),
        'gmlp_ws': nrm(ks[10], (DEPTH, A_HEADS, A_CHUNK, A_CHUNK), A_CHUNK ** -0.5),
        'gmlp_bs': 1.0 + nrm(ks[11], (DEPTH, A_HEADS, A_CHUNK), 0.02),
        'hgrn_lower_bounds': nrm(ks[12], (2, DEPTH, D_B), 0.1),
        'hgrn_norm_w': 1.0 + nrm(ks[13], (DEPTH, B_VAL_DIM), 0.02),
        'diff_lambda': nrm(ks[14], (DEPTH, 4, C_HEAD_DIM), 0.1),
        'diff_subln_w': 1.0 + nrm(ks[15], (DEPTH, C_VAL_DIM), 0.02),
        'w_out': nrm(ks[16], (DEPTH, D_MIX, D_MODEL), D_MIX ** -0.5),
        'final_norm_w': 1.0 + nrm(ks[17], (D_MODEL,), 0.02),
    }


def reference(x, c, ctx, c_ctx, ada_w, ada_b, norm_w, w_in, gmlp_ln_w, gmlp_ln_b, gmlp_ws, gmlp_bs,
              hgrn_lower_bounds, hgrn_norm_w, diff_lambda, diff_subln_w, w_out, final_norm_w):
    rope = axial_rope_tables(x.shape[1])
    lb_soft = jax.nn.softmax(hgrn_lower_bounds.astype(jnp.float32), axis=1)
    lb_cum = jnp.cumsum(lb_soft, axis=1)
    lb_all = lb_cum - lb_cum[:, :1]
    xc = ctx
    for layer in range(DEPTH):
        lam_init = 0.8 - 0.6 * math.exp(-0.3 * layer)
        x, xc = hybrid_layer(x, xc, c, c_ctx, ada_w[layer], ada_b[layer], norm_w[layer], w_in[layer],
                             gmlp_ln_w[layer], gmlp_ln_b[layer], gmlp_ws[layer], gmlp_bs[layer],
                             lb_all[0, layer], lb_all[1, layer], hgrn_norm_w[layer], diff_lambda[layer],
                             lam_init, diff_subln_w[layer], w_out[layer], rope, layer < DEPTH - 1)
    return rms_norm(x, final_norm_w)
```

```cpp
#include <hip/hip_runtime.h>
#include <hip/hip_bf16.h>
#include <hip/hip_cooperative_groups.h>
#include <cstdio>
#include <cstdint>
namespace cg = cooperative_groups;
__device__ __forceinline__ int tidx() { int t = threadIdx.x; asm volatile("" : "+v"(t)); return t; }
#define LAS __attribute__((address_space(3)))
namespace pg8 {
#define PG8_LAS __attribute__((address_space(3)))
typedef unsigned short bf16_t;
typedef short bf16x8 __attribute__((ext_vector_type(8)));
typedef float f32x4 __attribute__((ext_vector_type(4)));
typedef unsigned u32x4 __attribute__((ext_vector_type(4)));
constexpr int BM = 256, BK = 64, HALF = 128, HTB = HALF * BK * 2  , STAGE_BYTES = 8 * HTB, NXCD = 8, WGM = 8;

__host__ __device__ __forceinline__ int lds_byte(int r, int c) { const int st = (r >> 4) * 2 + (c >> 5), rr = r & 15, cc = c & 31, ob = rr * 64 + cc * 2; return st * 1024 + (ob ^ (((ob >> 9) & 1) << 5)); }
__host__ __device__ __forceinline__ void stage_rc(int b, int& R, int& C) { const int st = b / 1024, sb = b % 1024, swz = sb ^ (((sb >> 9) & 1) << 5); R = (st >> 1) * 16 + swz / 64; C = (st & 1) * 32 + (swz % 64) / 2; }
__host__ __device__ __forceinline__ int perm32(int rho) { const int n = rho >> 4, i = rho & 15; return 8 * (i >> 2) + 4 * n + (i & 3); }

struct Unit { int pm, pn; };
struct Gemm { const bf16_t* A; const bf16_t* Bt; int M, N, K; };

struct StaticOrder {
    int nM, nN, nwg, G, c;
    __host__ __device__ void init(int M, int N, int G_, int c_) { nM = M / BM; nN = N / BM; nwg = nM * nN; G = G_; c = c_; }
    __host__ __device__ bool next(int i, Unit& u) const {
        const long L = (long)i * G + c; if (L >= nwg) return false;
        int wgid = (int)L; { const int q = nwg / NXCD, r = nwg % NXCD, xcd = wgid % NXCD, off = wgid / NXCD; wgid = (xcd < r ? xcd * (q + 1) : r * (q + 1) + (xcd - r) * q) + off; }
        const int nig = WGM * nN, gid = wgid / nig, fm = gid * WGM, gsz = (nM - fm) < WGM ? (nM - fm) : WGM;
        u.pm = fm + ((wgid % nig) % gsz); u.pn = (wgid % nig) / gsz; return true;
    }
    __device__ __forceinline__ void a_ready(const Unit&) const {}
    __device__ __forceinline__ void done(const Unit&) const {}
};

__device__ __forceinline__ unsigned cvt_pk_bf16(float lo, float hi) { unsigned r; asm volatile("v_cvt_pk_bf16_f32 %0, %1, %2" : "=v"(r) : "v"(lo), "v"(hi)); return r; }
typedef float f32x2 __attribute__((ext_vector_type(2)));
__device__ __forceinline__ f32x2 gelu_pk(f32x2 v) {
    const f32x2 av = __builtin_elementwise_abs(v), d = av * 0.2316418882f + 1.0f;
    f32x2 t; t.x = __builtin_amdgcn_rcpf(d.x); t.y = __builtin_amdgcn_rcpf(d.y);
    f32x2 q = t * 0.5307027145f + (-0.7265760135f); q = q * t + 0.7107068705f; q = q * t + (-0.142248368f); q = q * t + 0.127414796f; q = q * t;
    const f32x2 s = (v * v) * (-0.72134752044f);
    f32x2 e; e.x = __builtin_amdgcn_exp2f(s.x); e.y = __builtin_amdgcn_exp2f(s.y);
    const f32x2 m = v * (q * e), r = v - m;
    f32x2 o; o.x = v.x < 0.f ? m.x : r.x; o.y = v.y < 0.f ? m.y : r.y; return o;
}

__device__ __forceinline__ float silu1(float x) { return x * __builtin_amdgcn_rcpf(1.f + __expf(-x)); }
struct EpiProj {
    static constexpr bool PERM = true, AFTER_DRAIN = false;
    bf16_t* O;
    __device__ __forceinline__ void operator()(const f32x4 (&acc)[2][2][4][2], const Unit& u, int wr, int wc, int fr, int fq) const {
        const int row0 = u.pm * BM + wr * 64 + fr; const int colt = u.pn * BM; const int col0 = colt + wc * 32 + 8 * fq;
        const int seg = colt >> 9;
        int mode = (int)((0x2200333320002211ULL >> (4 * seg)) & 15ULL);
        if (mode == 3 && u.pm >= 32) mode = 0;
        float ir[4] = {0.f, 0.f, 0.f, 0.f};
        if (mode == 3) { const int i0 = (wc & 1) * 16 + 4 * fq;
#pragma unroll
            for (int p = 0; p < 4; ++p) ir[p] = __builtin_amdgcn_exp2f(-(float)(i0 + p) * 0.41524101186092f) * 0.15915494309189535f; }
        const bool colaxis = (wc >> 1) != 0;
#pragma unroll
        for (int ai = 0; ai < 2; ++ai)
#pragma unroll
            for (int m = 0; m < 4; ++m) { const int row = row0 + ai * HALF + m * 16; bf16_t* rowp = O + (size_t)row * 8256 + col0;
                const float pos = (float)(colaxis ? (row & 63) : (row >> 6));
#pragma unroll
                for (int bj = 0; bj < 2; ++bj) { f32x4 v0 = acc[ai][bj][m][0], v1 = acc[ai][bj][m][1];
                    if (mode == 1) { f32x2 a = gelu_pk((f32x2){v0[0], v0[1]}), b = gelu_pk((f32x2){v0[2], v0[3]}), c = gelu_pk((f32x2){v1[0], v1[1]}), d = gelu_pk((f32x2){v1[2], v1[3]});
                        v0 = (f32x4){a.x, a.y, b.x, b.y}; v1 = (f32x4){c.x, c.y, d.x, d.y}; }
                    else if (mode == 2) {
#pragma unroll
                        for (int j = 0; j < 4; ++j) { v0[j] = silu1(v0[j]); v1[j] = silu1(v1[j]); } }
                    else if (mode == 3) {
                        float c0 = __builtin_amdgcn_cosf(pos * ir[0]), s0 = __builtin_amdgcn_sinf(pos * ir[0]);
                        float c1 = __builtin_amdgcn_cosf(pos * ir[1]), s1 = __builtin_amdgcn_sinf(pos * ir[1]);
                        float c2 = __builtin_amdgcn_cosf(pos * ir[2]), s2 = __builtin_amdgcn_sinf(pos * ir[2]);
                        float c3 = __builtin_amdgcn_cosf(pos * ir[3]), s3 = __builtin_amdgcn_sinf(pos * ir[3]);
                        f32x4 w0, w1;
                        w0[0] = v0[0] * c0 - v0[1] * s0; w0[1] = v0[1] * c0 + v0[0] * s0;
                        w0[2] = v0[2] * c1 - v0[3] * s1; w0[3] = v0[3] * c1 + v0[2] * s1;
                        w1[0] = v1[0] * c2 - v1[1] * s2; w1[1] = v1[1] * c2 + v1[0] * s2;
                        w1[2] = v1[2] * c3 - v1[3] * s3; w1[3] = v1[3] * c3 + v1[2] * s3;
                        v0 = w0; v1 = w1; }
                    u32x4 w; w.x = cvt_pk_bf16(v0[0], v0[1]); w.y = cvt_pk_bf16(v0[2], v0[3]); w.z = cvt_pk_bf16(v1[0], v1[1]); w.w = cvt_pk_bf16(v1[2], v1[3]);
                    *(u32x4*)(rowp + bj * HALF) = w; } }
    }
};
struct EpiOut {
    static constexpr bool PERM = false, AFTER_DRAIN = false;
    float* X; const float* Xin; const float* mod;
    __device__ __forceinline__ void operator()(const f32x4 (&acc)[2][2][4][2], const Unit& u, int wr, int wc, int fr, int fq) const {
        const int row0 = u.pm * BM + wr * 64 + fr, col0 = u.pn * BM + wc * 32 + 4 * fq;
        const float* g = mod + (u.pm >= 32 ? 6144 : 0) + 4096;
        f32x4 gv[2][2];
#pragma unroll
        for (int bj = 0; bj < 2; ++bj)
#pragma unroll
            for (int n = 0; n < 2; ++n) gv[bj][n] = *(const f32x4*)(g + col0 + bj * HALF + n * 16);
#pragma unroll
        for (int ai = 0; ai < 2; ++ai) { f32x4 xin[4][2][2];
#pragma unroll
            for (int m = 0; m < 4; ++m) { const float* rowi = Xin + (size_t)(row0 + ai * HALF + m * 16) * 2048 + col0;
#pragma unroll
                for (int bj = 0; bj < 2; ++bj)
#pragma unroll
                    for (int n = 0; n < 2; ++n) xin[m][bj][n] = *(const f32x4*)(rowi + bj * HALF + n * 16); }
            asm volatile("" ::: "memory");
#pragma unroll
            for (int m = 0; m < 4; ++m) { float* rowp = X + (size_t)(row0 + ai * HALF + m * 16) * 2048 + col0;
#pragma unroll
                for (int bj = 0; bj < 2; ++bj)
#pragma unroll
                    for (int n = 0; n < 2; ++n) *(f32x4*)(rowp + bj * HALF + n * 16) = xin[m][bj][n] + gv[bj][n] * acc[ai][bj][m][n]; }
            asm volatile("" ::: "memory"); }
    }
};
struct MainOrder : StaticOrder {
    __device__ bool next(int i, Unit& u) const {
        if (!StaticOrder::next(i, u)) return false;
        if (u.pn >= 28 && u.pm >= 29) { const int j = (31 - u.pm) * 4 + (u.pn - 28); u.pm = 32; u.pn = (j < 6) ? j : 8 + (j - 6); }
        return true;
    }
};
struct TailOrder {
    int t;
    __device__ bool next(int i, Unit& u) const {
        if (i != 0 || t >= 32) return false;
        if (t < 2) { u.pm = 32; u.pn = 6 + t; } else if (t < 20) { u.pm = 32; u.pn = 14 + (t - 2); } else { const int j = t - 20; u.pm = 31 - (j >> 2); u.pn = 28 + (j & 3); }
        return true;
    }
    __device__ __forceinline__ void a_ready(const Unit&) const {}
    __device__ __forceinline__ void done(const Unit&) const {}
};
template <class Epi, class Sched, bool ALIGN_EPI = false, bool SP2 = false>
__device__ __forceinline__ void gemm_phase(PG8_LAS unsigned char* lds, const Gemm g, const Sched& S, const Epi& E) {
    const int tid = tidx(), wid = __builtin_amdgcn_readfirstlane(tid >> 6), lane = tid & 63, wr = wid >> 2, wc = wid & 3, fr = lane & 15, fq = lane >> 4;
    const int K = g.K, nt = K / BK;
    unsigned voffA[2], voffB[2];
#pragma unroll
    for (int i = 0; i < 2; ++i) { int R, C; stage_rc(tid * 16 + i * 8192, R, C); const int Rb = Epi::PERM ? ((R & ~31) + perm32(R & 31)) : R;
        voffA[i] = (unsigned)(R * K + C) * 2u; voffB[i] = (unsigned)(Rb * K + C) * 2u; }
    const size_t kstep = (size_t)(BK * 2);
    const size_t hstep = (size_t)HALF * K * 2;
    const size_t tstep = 2 * hstep;
    const unsigned ldsw = (unsigned)wid * 1024u;
    const int aoff = lds_byte(wr * 64 + fr, fq * 8), boff = lds_byte(wc * 32 + fr, fq * 8);
#define PG8_SA(b, h) (((b) * 2 + (h)) * HTB)
#define PG8_SB(b, h) ((4 + (b) * 2 + (h)) * HTB)
#define PG8_STAGE(bufoff, gbase, voff) do { _Pragma("unroll") for (int _i = 0; _i < 2; ++_i) \
        __builtin_amdgcn_global_load_lds((const unsigned*)((const char*)(gbase) + (voff)[_i]), (PG8_LAS unsigned*)(lds + (bufoff) + ldsw + _i * 8192), 16, 0, 0); } while (0)
#define PG8_LDA(dst, b, h) do { _Pragma("unroll") for (int m = 0; m < 4; ++m) _Pragma("unroll") for (int k = 0; k < 2; ++k) dst[m][k] = *(const PG8_LAS bf16x8*)(lds + PG8_SA(b, h) + aoff + m * 2048 + k * 1024); } while (0)
#define PG8_LDB(dst, b, h) do { _Pragma("unroll") for (int n = 0; n < 2; ++n) _Pragma("unroll") for (int k = 0; k < 2; ++k) dst[n][k] = *(const PG8_LAS bf16x8*)(lds + PG8_SB(b, h) + boff + n * 2048 + k * 1024); } while (0)
#define PG8_MMA(ai, bj, At, Bt) do { __builtin_amdgcn_s_setprio(1); _Pragma("unroll") for (int m = 0; m < 4; ++m) _Pragma("unroll") for (int n = 0; n < 2; ++n) _Pragma("unroll") for (int k = 0; k < 2; ++k) \
        acc[ai][bj][m][n] = __builtin_amdgcn_mfma_f32_16x16x32_bf16(Bt[n][k], At[m][k], acc[ai][bj][m][n], 0, 0, 0); __builtin_amdgcn_s_setprio(0); } while (0)
#define PG8_WAIT_V(n) asm volatile("s_waitcnt vmcnt(" #n ")" ::: "memory")
#define PG8_WAIT_L(n) asm volatile("s_waitcnt lgkmcnt(" #n ")" ::: "memory")
#define PG8_BAR __builtin_amdgcn_s_barrier()
#define PG8_SCHED __builtin_amdgcn_sched_barrier(0)
    Unit cur, nxt; int ui = 0;
    if (!S.next(0, cur)) return;
    f32x4 acc[2][2][4][2];
#pragma unroll
    for (int a = 0; a < 2; ++a)
#pragma unroll
        for (int b = 0; b < 2; ++b)
#pragma unroll
            for (int m = 0; m < 4; ++m)
#pragma unroll
                for (int n = 0; n < 2; ++n) acc[a][b][m][n] = (f32x4){0.f, 0.f, 0.f, 0.f};
    bf16x8 At[4][2], B0[2][2], B1[2][2];
    const char* cA = (const char*)g.A + (size_t)cur.pm * tstep; const char* cB = (const char*)g.Bt + (size_t)cur.pn * tstep;
    S.a_ready(cur);
    if constexpr (SP2) {
        PG8_STAGE(PG8_SB(0, 0), cB, voffB); PG8_STAGE(PG8_SB(0, 1), cB + hstep, voffB); PG8_STAGE(PG8_SA(0, 0), cA, voffA); PG8_STAGE(PG8_SA(0, 1), cA + hstep, voffA);
        if (wr == 1) PG8_BAR;
        PG8_WAIT_V(2); PG8_BAR;
        PG8_STAGE(PG8_SB(1, 0), cB + kstep, voffB); PG8_STAGE(PG8_SA(1, 0), cA + kstep, voffA); PG8_STAGE(PG8_SB(1, 1), cB + hstep + kstep, voffB);
        PG8_WAIT_V(6); PG8_BAR;
    } else {
        PG8_STAGE(PG8_SB(0, 0), cB, voffB); PG8_STAGE(PG8_SA(0, 0), cA, voffA); PG8_STAGE(PG8_SB(0, 1), cB + hstep, voffB); PG8_STAGE(PG8_SA(0, 1), cA + hstep, voffA);
        if (wr == 1) PG8_BAR;
        PG8_WAIT_V(4); PG8_BAR;
        PG8_STAGE(PG8_SB(1, 0), cB + kstep, voffB); PG8_STAGE(PG8_SA(1, 0), cA + kstep, voffA); PG8_STAGE(PG8_SB(1, 1), cB + hstep + kstep, voffB);
        PG8_WAIT_V(6); PG8_BAR;
    }
    for (;;) {
        const bool has_next = S.next(ui + 1, nxt);
        const char* nA = has_next ? (const char*)g.A + (size_t)nxt.pm * tstep : cA; const char* nB = has_next ? (const char*)g.Bt + (size_t)nxt.pn * tstep : cB;
        for (int t = 0; t < nt; t += 2) {
            const bool last = (t == nt - 2);
            const char* a1 = cA + (size_t)(t + 1) * kstep;
            const char* a2 = last ? nA : cA + (size_t)(t + 2) * kstep; const char* b2 = last ? nB : cB + (size_t)(t + 2) * kstep;
            const char* a3 = a2 + kstep; const char* b3 = b2 + kstep;
            if (last && has_next) S.a_ready(nxt);
            if constexpr (SP2) {
            PG8_LDB(B0, 0, 0); PG8_LDB(B1, 0, 1); PG8_SCHED; PG8_LDA(At, 0, 0); PG8_STAGE(PG8_SA(1, 1), a1 + hstep, voffA);
            PG8_WAIT_V(8); PG8_WAIT_L(0); PG8_BAR; PG8_MMA(0, 0, At, B0); PG8_MMA(0, 1, At, B1); PG8_BAR; PG8_SCHED;
            PG8_LDA(At, 0, 1); PG8_STAGE(PG8_SB(0, 0), b2, voffB); PG8_STAGE(PG8_SB(0, 1), b2 + hstep, voffB); PG8_STAGE(PG8_SA(0, 0), a2, voffA);
            PG8_WAIT_V(8); PG8_WAIT_L(0); PG8_BAR; PG8_MMA(1, 0, At, B0); PG8_MMA(1, 1, At, B1); PG8_BAR; PG8_SCHED;
            PG8_LDB(B0, 1, 0); PG8_LDB(B1, 1, 1); PG8_SCHED; PG8_LDA(At, 1, 0); PG8_STAGE(PG8_SA(0, 1), a2 + hstep, voffA);
            PG8_WAIT_V(8); PG8_WAIT_L(0); PG8_BAR; PG8_MMA(0, 0, At, B0); PG8_MMA(0, 1, At, B1); PG8_BAR; PG8_SCHED;
            PG8_LDA(At, 1, 1); PG8_STAGE(PG8_SB(1, 0), b3, voffB); PG8_STAGE(PG8_SB(1, 1), b3 + hstep, voffB); PG8_STAGE(PG8_SA(1, 0), a3, voffA);
            PG8_WAIT_V(8); PG8_WAIT_L(0); PG8_BAR; PG8_MMA(1, 0, At, B0); PG8_MMA(1, 1, At, B1); PG8_BAR; PG8_SCHED;
            } else {
            PG8_LDB(B0, 0, 0); PG8_SCHED; PG8_LDA(At, 0, 0); PG8_STAGE(PG8_SA(1, 1), a1 + hstep, voffA);
            PG8_WAIT_L(8); PG8_BAR; PG8_WAIT_L(0); PG8_MMA(0, 0, At, B0); PG8_BAR; PG8_SCHED;
            PG8_LDB(B1, 0, 1); PG8_STAGE(PG8_SB(0, 0), b2, voffB);
            PG8_BAR; PG8_WAIT_L(0); PG8_MMA(0, 1, At, B1); PG8_BAR;
            PG8_LDA(At, 0, 1); PG8_STAGE(PG8_SA(0, 0), a2, voffA);
            PG8_BAR; PG8_WAIT_L(0); PG8_MMA(1, 0, At, B0); PG8_BAR; PG8_SCHED;
            PG8_STAGE(PG8_SB(0, 1), b2 + hstep, voffB);
            PG8_WAIT_V(6); PG8_BAR; PG8_MMA(1, 1, At, B1); PG8_BAR;
            PG8_LDB(B0, 1, 0); PG8_SCHED; PG8_LDA(At, 1, 0); PG8_STAGE(PG8_SA(0, 1), a2 + hstep, voffA);
            PG8_WAIT_L(8); PG8_BAR; PG8_WAIT_L(0); PG8_MMA(0, 0, At, B0); PG8_BAR; PG8_SCHED;
            PG8_LDB(B1, 1, 1); PG8_STAGE(PG8_SB(1, 0), b3, voffB);
            PG8_BAR; PG8_WAIT_L(0); PG8_MMA(0, 1, At, B1); PG8_BAR;
            PG8_LDA(At, 1, 1); PG8_STAGE(PG8_SA(1, 0), a3, voffA);
            PG8_BAR; PG8_WAIT_L(0); PG8_MMA(1, 0, At, B0); PG8_BAR; PG8_SCHED;
            PG8_STAGE(PG8_SB(1, 1), b3 + hstep, voffB);
            PG8_WAIT_V(6); PG8_BAR; PG8_MMA(1, 1, At, B1); PG8_BAR;
            }
        }
        if constexpr (ALIGN_EPI) { if (wr == 0) PG8_BAR; }
        if constexpr (!Epi::AFTER_DRAIN) { E(acc, cur, wr, wc, fr, fq); S.done(cur); }
        if (!has_next) break;
#pragma unroll
        for (int a = 0; a < 2; ++a)
#pragma unroll
            for (int b = 0; b < 2; ++b)
#pragma unroll
                for (int m = 0; m < 4; ++m)
#pragma unroll
                    for (int n = 0; n < 2; ++n) acc[a][b][m][n] = (f32x4){0.f, 0.f, 0.f, 0.f};
        cur = nxt; cA = nA; cB = nB; ++ui;
        if constexpr (ALIGN_EPI) { if (wr == 1) PG8_BAR; }
    }
    PG8_WAIT_V(0);
    if constexpr (!ALIGN_EPI) { if (wr == 0) PG8_BAR; }
    PG8_BAR;
    if constexpr (Epi::AFTER_DRAIN) { E.fused(acc, cur, wr, wc, fr, fq, lds, wid, lane); S.done(cur); }
#undef PG8_SA
#undef PG8_SB
#undef PG8_STAGE
#undef PG8_LDA
#undef PG8_LDB
#undef PG8_MMA
#undef PG8_WAIT_V
#undef PG8_WAIT_L
#undef PG8_BAR
#undef PG8_SCHED
}
}
namespace att {
using bf16 = __hip_bfloat16;
constexpr int   D = 128, NW = 8, QBLK = 32, KVBLK = 64;
constexpr float SCALE = 0.088388347648318440f;
constexpr float THR = 8.f;
constexpr int SDEPTH = 2;
constexpr int LDQ = 8256, LDK = 8256, LDO = 2048;
constexpr size_t SHM_V = KVBLK * D * 2, SHM_K = KVBLK * D * 2, SHM_ATTN = 2 * SHM_V + 2 * SHM_K + NW * 64 * 4;
using bf16x8 = __attribute__((ext_vector_type(8))) short;
using s16x4  = __attribute__((ext_vector_type(4))) short;
using f32x16 = __attribute__((ext_vector_type(16))) float;
using f32x8  = __attribute__((ext_vector_type(8))) float;
using u32x4  = __attribute__((ext_vector_type(4))) unsigned;
#define KSWZ(row, colB) ((row) * 256 + ((colB) ^ (((row) & 7) << 4)))
#define SBAR() __builtin_amdgcn_sched_barrier(0)
__device__ __forceinline__ int crow(int r, int hi) { return (r & 3) + 8 * (r >> 2) + 4 * hi; }
__device__ __forceinline__ unsigned cvtpk(float lo, float hi) {
  unsigned r; asm volatile("v_cvt_pk_bf16_f32 %0, %1, %2" : "=v"(r) : "v"(lo), "v"(hi)); return r;
}
template <typename TIn> struct Stage;
template <> struct Stage<bf16>  { using T = bf16x8;
  __device__ static __forceinline__ T ld8(const bf16* p) { return *reinterpret_cast<const bf16x8*>(p); }
  __device__ static __forceinline__ bf16x8 tobf(T x) { return x; } };
template <> struct Stage<float> { using T = f32x8;
  __device__ static __forceinline__ T ld8(const float* p) { return *reinterpret_cast<const f32x8*>(p); }
  __device__ static __forceinline__ bf16x8 tobf(T x) {
    u32x4 w = {cvtpk(x[0], x[1]), cvtpk(x[2], x[3]), cvtpk(x[4], x[5]), cvtpk(x[6], x[7])}; return *reinterpret_cast<bf16x8*>(&w); } };

__device__ __forceinline__ void partialSM(f32x16& p0, f32x16& p1, float& m_reg, float& mn, float& alpha) {
  constexpr float C = SCALE * 1.4426950408889634f;
  float pmax = p0[0]; for (int r = 1; r < 16; ++r) pmax = fmaxf(pmax, p0[r]); for (int r = 0; r < 16; ++r) pmax = fmaxf(pmax, p1[r]);
  { auto rr = __builtin_amdgcn_permlane32_swap(__float_as_uint(pmax), __float_as_uint(pmax), false, false);
    pmax = fmaxf(__uint_as_float(rr[0]), __uint_as_float(rr[1])); }
  if (__builtin_expect(__all(pmax - m_reg <= THR / SCALE), 1)) { mn = m_reg; alpha = 1.f; }
  else { mn = fmaxf(m_reg, pmax); alpha = __builtin_amdgcn_exp2f((m_reg - mn) * C); m_reg = mn; }
  float mnC = -mn * C;
  for (int r = 0; r < 16; ++r) p0[r] = fmaf(p0[r], C, mnC); for (int r = 0; r < 16; ++r) p1[r] = fmaf(p1[r], C, mnC);
  for (int r = 0; r < 16; ++r) p0[r] = __builtin_amdgcn_exp2f(p0[r]);
}
__device__ __forceinline__ void finishSM(f32x16& p0, f32x16& p1, float alpha, float& l_reg, bf16x8& pa0, bf16x8& pa1, bf16x8& pa2, bf16x8& pa3) {
  for (int r = 0; r < 16; ++r) p1[r] = __builtin_amdgcn_exp2f(p1[r]);
  float ps = 0; for (int r = 0; r < 16; ++r) ps += p0[r]; for (int r = 0; r < 16; ++r) ps += p1[r];
  { auto rr = __builtin_amdgcn_permlane32_swap(__float_as_uint(ps), __float_as_uint(ps), false, false);
    ps = __uint_as_float(rr[0]) + __uint_as_float(rr[1]); }
  l_reg = l_reg * alpha + ps;
#define PK4(P, BASE, OUT) do { unsigned a0 = cvtpk(P[BASE + 0], P[BASE + 1]), a1 = cvtpk(P[BASE + 2], P[BASE + 3]);   \
    unsigned b0 = cvtpk(P[BASE + 4], P[BASE + 5]), b1 = cvtpk(P[BASE + 6], P[BASE + 7]);                              \
    auto r0 = __builtin_amdgcn_permlane32_swap(a0, b0, false, false); auto r1 = __builtin_amdgcn_permlane32_swap(a1, b1, false, false); \
    u32x4 w = {r0[0], r1[0], r0[1], r1[1]}; OUT = *reinterpret_cast<bf16x8*>(&w); } while (0)
  PK4(p0, 0, pa0); PK4(p0, 8, pa1); PK4(p1, 0, pa2); PK4(p1, 8, pa3);
#undef PK4
}
__device__ __forceinline__ void qkt(f32x16& p0, f32x16& p1, const bf16* Ks, const bf16x8* qr, int r32, int hi) {
  p0 = f32x16{}; p1 = f32x16{};
  for (int d0 = 0; d0 < 8; ++d0) { int cb = (d0 * 16 + hi * 8) * 2;
    bf16x8 b0 = *reinterpret_cast<const bf16x8*>((const char*)Ks + KSWZ(r32, cb));
    bf16x8 b1 = *reinterpret_cast<const bf16x8*>((const char*)Ks + KSWZ(32 + r32, cb));
    p0 = __builtin_amdgcn_mfma_f32_32x32x16_bf16(b0, qr[d0], p0, 0, 0, 0);
    p1 = __builtin_amdgcn_mfma_f32_32x32x16_bf16(b1, qr[d0], p1, 0, 0, 0); }
}
__device__ __forceinline__ int v_st(int k, int c) { const int kk = (k & ~0xC) | ((k & 4) << 1) | ((k & 8) >> 1); return ((kk >> 3) * 4 + (c >> 5)) * 512 + ((kk & 7) * 32 + (c & 31)) * 2; }
__device__ __forceinline__ int v_rd_base(int lane) { return ((lane & 3) << 3) | (((lane >> 2) & 3) << 6) | (((lane >> 4) & 1) << 5) | (((lane >> 5) & 1) << 8); }
constexpr int v_rd_off(int d0, int ks, int half) { return d0 * 512 + ks * 4096 + half * 2048; }
template <int OFF> __device__ __forceinline__ s16x4 tr_read(int vb) {
  s16x4 r; asm volatile("ds_read_b64_tr_b16 %0, %1 offset:%2" : "=&v"(r) : "v"(vb), "i"(OFF) : "memory"); return r;
}
template <int D0> __device__ __forceinline__ void pv_one(f32x16& od, int vb, bf16x8 pa0, bf16x8 pa1, bf16x8 pa2, bf16x8 pa3) {
  const s16x4 l0 = tr_read<v_rd_off(D0, 0, 0)>(vb), h0 = tr_read<v_rd_off(D0, 0, 1)>(vb), l1 = tr_read<v_rd_off(D0, 1, 0)>(vb), h1 = tr_read<v_rd_off(D0, 1, 1)>(vb);
  const s16x4 l2 = tr_read<v_rd_off(D0, 2, 0)>(vb), h2 = tr_read<v_rd_off(D0, 2, 1)>(vb), l3 = tr_read<v_rd_off(D0, 3, 0)>(vb), h3 = tr_read<v_rd_off(D0, 3, 1)>(vb);
  asm volatile("s_waitcnt lgkmcnt(0)" ::: "memory"); SBAR();
#define PK(L, H) (bf16x8){L[0], L[1], L[2], L[3], H[0], H[1], H[2], H[3]}
  od = __builtin_amdgcn_mfma_f32_32x32x16_bf16(pa0, PK(l0, h0), od, 0, 0, 0);
  od = __builtin_amdgcn_mfma_f32_32x32x16_bf16(pa1, PK(l1, h1), od, 0, 0, 0);
  od = __builtin_amdgcn_mfma_f32_32x32x16_bf16(pa2, PK(l2, h2), od, 0, 0, 0);
  od = __builtin_amdgcn_mfma_f32_32x32x16_bf16(pa3, PK(l3, h3), od, 0, 0, 0);
#undef PK
}
__device__ __forceinline__ void pv_d0(f32x16* o, int vb, bf16x8 pa0, bf16x8 pa1, bf16x8 pa2, bf16x8 pa3) {
  pv_one<0>(o[0], vb, pa0, pa1, pa2, pa3); pv_one<1>(o[1], vb, pa0, pa1, pa2, pa3); pv_one<2>(o[2], vb, pa0, pa1, pa2, pa3); pv_one<3>(o[3], vb, pa0, pa1, pa2, pa3);
}

template <typename TQ>
__device__ __forceinline__ void attn_dense_body(const TQ* __restrict__ Qb, const bf16* __restrict__ Kh, const bf16* __restrict__ Vh,
                                                float* __restrict__ Ob, int seq, char* lds) {
  using St = Stage<bf16>; using SQ = Stage<TQ>;
  const int tid = tidx(), wid = tid >> 6, lane = tid & 63, r32 = lane & 31, hi = lane >> 5;
  bf16* V_lds = (bf16*)lds; bf16* K_lds = (bf16*)(lds + 2 * SHM_V);
  float* ws = (float*)(lds + 2 * SHM_V + 2 * SHM_K) + wid * 64; float* li_l = ws; float* al_l = ws + 32;
  float m_reg = -1e30f, l_reg = 0; f32x16 o[4] = {}; bf16x8 qr[8];
  const TQ* Qw = Qb + (long)(wid * QBLK + r32) * LDQ + hi * 8;
#pragma unroll
  for (int d0 = 0; d0 < 8; ++d0) qr[d0] = SQ::tobf(SQ::ld8(Qw + d0 * 16));
  const int sr = tid >> 4, sc = (tid & 15) * 8, vst0 = v_st(sr, sc), vst1 = v_st(32 + sr, sc);
  const int vb0 = (int)(uintptr_t)V_lds + v_rd_base(lane);
  struct { typename St::T vs0, vs1, ks0, ks1; } sr_[SDEPTH];
#define SLOAD(i, k0) do { sr_[i].vs0 = St::ld8(&Vh[(long)((k0) + sr) * LDK + sc]); sr_[i].vs1 = St::ld8(&Vh[(long)((k0) + 32 + sr) * LDK + sc]); \
    sr_[i].ks0 = St::ld8(&Kh[(long)((k0) + sr) * LDK + sc]); sr_[i].ks1 = St::ld8(&Kh[(long)((k0) + 32 + sr) * LDK + sc]); } while (0)
#define SWRITE(b, i) do { *(bf16x8*)((char*)V_lds + (b) * SHM_V + vst0) = St::tobf(sr_[i].vs0);          \
    *(bf16x8*)((char*)V_lds + (b) * SHM_V + vst1) = St::tobf(sr_[i].vs1); int kc = sc * 2;               \
    *(bf16x8*)((char*)K_lds + (b) * SHM_K + KSWZ(sr, kc)) = St::tobf(sr_[i].ks0);                       \
    *(bf16x8*)((char*)K_lds + (b) * SHM_K + KSWZ(32 + sr, kc)) = St::tobf(sr_[i].ks1); } while (0)
#define SWAIT() do { if constexpr (SDEPTH == 2) asm volatile("s_waitcnt vmcnt(4)" ::: "memory"); else asm volatile("s_waitcnt vmcnt(0)" ::: "memory"); } while (0)
#define RESC(a) do { if (__any((a) < 1.f)) { if (hi == 0) al_l[r32] = (a); asm volatile("s_waitcnt lgkmcnt(0)" ::: "memory"); \
    for (int d = 0; d < 4; ++d) for (int r = 0; r < 16; ++r) o[d][r] *= al_l[crow(r, hi)]; } } while (0)
  f32x16 pA0, pA1, pB0, pB1; float mnA, mnB, alA, alB; bf16x8 pa0, pa1, pa2, pa3; const int NT = seq / KVBLK;
  constexpr int SE = 0, SO = SDEPTH - 1;
  SLOAD(SE, 0); asm volatile("s_waitcnt vmcnt(0)" ::: "memory"); SWRITE(0, SE); __syncthreads();
  qkt(pA0, pA1, K_lds, qr, r32, hi); partialSM(pA0, pA1, m_reg, mnA, alA);
  SLOAD(SO, KVBLK); if constexpr (SDEPTH == 2) { if (2 < NT) SLOAD(SE, 2 * KVBLK); }
  SWAIT(); SWRITE(1, SO); __syncthreads();
  for (int j = 1; j + 1 < NT; j += 2) {
    SBAR(); qkt(pB0, pB1, (bf16*)((char*)K_lds + SHM_K), qr, r32, hi);
    finishSM(pA0, pA1, alA, l_reg, pa0, pa1, pa2, pa3); SBAR();
    SLOAD(SO, (j + SDEPTH) * KVBLK); SBAR();
    pv_d0(o, vb0, pa0, pa1, pa2, pa3); partialSM(pB0, pB1, m_reg, mnB, alB);
    __syncthreads(); SWAIT(); SWRITE(0, SE);
    RESC(alB); __syncthreads();
    SBAR(); qkt(pA0, pA1, K_lds, qr, r32, hi);
    finishSM(pB0, pB1, alB, l_reg, pa0, pa1, pa2, pa3); SBAR();
    if (SDEPTH == 1 || j + 3 < NT) SLOAD(SE, (j + 1 + SDEPTH) * KVBLK); SBAR();
    pv_d0(o, vb0 + (int)SHM_V, pa0, pa1, pa2, pa3); partialSM(pA0, pA1, m_reg, mnA, alA);
    __syncthreads(); SWAIT(); SWRITE(1, SO);
    RESC(alA); __syncthreads();
  }
  SBAR(); qkt(pB0, pB1, (bf16*)((char*)K_lds + SHM_K), qr, r32, hi);
  finishSM(pA0, pA1, alA, l_reg, pa0, pa1, pa2, pa3); SBAR();
  pv_d0(o, vb0, pa0, pa1, pa2, pa3); partialSM(pB0, pB1, m_reg, mnB, alB);
  __syncthreads(); RESC(alB);
  finishSM(pB0, pB1, alB, l_reg, pa0, pa1, pa2, pa3); SBAR();
  pv_d0(o, vb0 + (int)SHM_V, pa0, pa1, pa2, pa3);
  if (hi == 0) li_l[r32] = l_reg; asm volatile("s_waitcnt lgkmcnt(0)" ::: "memory");
  float rli[16];
#pragma unroll
  for (int r = 0; r < 16; ++r) rli[r] = __builtin_amdgcn_rcpf(li_l[crow(r, hi)]);
  float* Ow = Ob + (long)(wid * QBLK) * LDO;
#pragma unroll
  for (int r = 0; r < 16; ++r) { int orow = crow(r, hi);
    for (int d0 = 0; d0 < 4; ++d0) Ow[(long)orow * LDO + d0 * 32 + r32] = o[d0][r] * rli[r]; }
#undef SLOAD
#undef SWRITE
#undef SWAIT
#undef RESC
}
struct PvT { s16x4 t[16]; };
template <int DA, int DB> __device__ __forceinline__ void pv2_issue(PvT& T, int vb) {
  T.t[0] = tr_read<v_rd_off(DA, 0, 0)>(vb); T.t[1] = tr_read<v_rd_off(DA, 0, 1)>(vb); T.t[2] = tr_read<v_rd_off(DA, 1, 0)>(vb); T.t[3] = tr_read<v_rd_off(DA, 1, 1)>(vb);
  T.t[4] = tr_read<v_rd_off(DA, 2, 0)>(vb); T.t[5] = tr_read<v_rd_off(DA, 2, 1)>(vb); T.t[6] = tr_read<v_rd_off(DA, 3, 0)>(vb); T.t[7] = tr_read<v_rd_off(DA, 3, 1)>(vb);
  T.t[8] = tr_read<v_rd_off(DB, 0, 0)>(vb); T.t[9] = tr_read<v_rd_off(DB, 0, 1)>(vb); T.t[10] = tr_read<v_rd_off(DB, 1, 0)>(vb); T.t[11] = tr_read<v_rd_off(DB, 1, 1)>(vb);
  T.t[12] = tr_read<v_rd_off(DB, 2, 0)>(vb); T.t[13] = tr_read<v_rd_off(DB, 2, 1)>(vb); T.t[14] = tr_read<v_rd_off(DB, 3, 0)>(vb); T.t[15] = tr_read<v_rd_off(DB, 3, 1)>(vb);
}
__device__ __forceinline__ void pv2_mma(f32x16& oa, f32x16& ob, const PvT& T, bf16x8 pa0, bf16x8 pa1, bf16x8 pa2, bf16x8 pa3) {
  asm volatile("s_waitcnt lgkmcnt(0)" ::: "memory"); SBAR();
#define PK(L, H) (bf16x8){L[0], L[1], L[2], L[3], H[0], H[1], H[2], H[3]}
  oa = __builtin_amdgcn_mfma_f32_32x32x16_bf16(pa0, PK(T.t[0], T.t[1]), oa, 0, 0, 0);
  ob = __builtin_amdgcn_mfma_f32_32x32x16_bf16(pa0, PK(T.t[8], T.t[9]), ob, 0, 0, 0);
  oa = __builtin_amdgcn_mfma_f32_32x32x16_bf16(pa1, PK(T.t[2], T.t[3]), oa, 0, 0, 0);
  ob = __builtin_amdgcn_mfma_f32_32x32x16_bf16(pa1, PK(T.t[10], T.t[11]), ob, 0, 0, 0);
  oa = __builtin_amdgcn_mfma_f32_32x32x16_bf16(pa2, PK(T.t[4], T.t[5]), oa, 0, 0, 0);
  ob = __builtin_amdgcn_mfma_f32_32x32x16_bf16(pa2, PK(T.t[12], T.t[13]), ob, 0, 0, 0);
  oa = __builtin_amdgcn_mfma_f32_32x32x16_bf16(pa3, PK(T.t[6], T.t[7]), oa, 0, 0, 0);
  ob = __builtin_amdgcn_mfma_f32_32x32x16_bf16(pa3, PK(T.t[14], T.t[15]), ob, 0, 0, 0);
#undef PK
}
__device__ __forceinline__ void attn_dv256_body(const bf16* __restrict__ Qb, const bf16* __restrict__ Kh, const bf16* __restrict__ Vh,
                                                float* __restrict__ Ob, int seq, float kmax, char* lds) {
  using St = Stage<bf16>;
  const int tid = tidx(), wid = tid >> 6, lane = tid & 63, r32 = lane & 31, hi = lane >> 5;
  const int rg = wid & 3, kh = wid >> 2;
  char* V_lds = lds; char* K_lds = lds + 65536; char* XCH = lds + 98304; float* LI = (float*)(lds + 131072);
  f32x16 o[4] = {}; bf16x8 qr[8];
  const bf16* Qw = Qb + (long)(rg * 32 + r32) * LDQ + hi * 8;
#pragma unroll
  for (int d0 = 0; d0 < 8; ++d0) qr[d0] = St::ld8(Qw + d0 * 16);
  float qq = 0.f;
#pragma unroll
  for (int d0 = 0; d0 < 8; ++d0)
#pragma unroll
    for (int e = 0; e < 8; ++e) { const float v = __uint_as_float(((unsigned)(unsigned short)qr[d0][e]) << 16); qq += v * v; }
  qq += __shfl_xor(qq, 32);
  constexpr float C = SCALE * 1.4426950408889634f;
  const float mC = -sqrtf(qq) * kmax * C * 1.002f;
  float l_reg = 0.f;
  const int sr = tid >> 4, sc = (tid & 15) * 8, vst0 = v_st(sr, sc), vst1 = v_st(32 + sr, sc);
  const int vb0 = (int)(uintptr_t)V_lds + kh * 16384 + v_rd_base(lane);
  bf16x8 kr0, kr1, vr0, vr1, vr2, vr3;
#define KLOAD(k0) do { kr0 = St::ld8(&Kh[(long)((k0) + sr) * LDK + sc]); kr1 = St::ld8(&Kh[(long)((k0) + 32 + sr) * LDK + sc]); } while (0)
#define VLOAD(k0) do { vr0 = St::ld8(&Vh[(long)((k0) + sr) * LDK + sc]); vr1 = St::ld8(&Vh[(long)((k0) + 32 + sr) * LDK + sc]); \
    vr2 = St::ld8(&Vh[(long)((k0) + sr) * LDK + 128 + sc]); vr3 = St::ld8(&Vh[(long)((k0) + 32 + sr) * LDK + 128 + sc]); } while (0)
#define KWRITE(b) do { *(bf16x8*)(K_lds + (b) * 16384 + KSWZ(sr, sc * 2)) = kr0; *(bf16x8*)(K_lds + (b) * 16384 + KSWZ(32 + sr, sc * 2)) = kr1; } while (0)
#define VWRITE(b) do { *(bf16x8*)(V_lds + ((b) * 2) * 16384 + vst0) = vr0; *(bf16x8*)(V_lds + ((b) * 2) * 16384 + vst1) = vr1; \
    *(bf16x8*)(V_lds + ((b) * 2 + 1) * 16384 + vst1) = vr2; *(bf16x8*)(V_lds + ((b) * 2 + 1) * 16384 + vst0) = vr3; } while (0)
#define QKH(P, b) do { P = f32x16{}; _Pragma("unroll") for (int d0 = 0; d0 < 8; ++d0) { const int cb = (d0 * 16 + hi * 8) * 2; \
    const bf16x8 kf = *reinterpret_cast<const bf16x8*>(K_lds + (b) * 16384 + KSWZ(32 * kh + r32, cb)); P = __builtin_amdgcn_mfma_f32_32x32x16_bf16(kf, qr[d0], P, 0, 0, 0); } } while (0)
#define PK4(P, BASE, OUT) do { unsigned a0 = cvtpk(P[BASE + 0], P[BASE + 1]), a1 = cvtpk(P[BASE + 2], P[BASE + 3]);   \
    unsigned b0 = cvtpk(P[BASE + 4], P[BASE + 5]), b1 = cvtpk(P[BASE + 6], P[BASE + 7]);                              \
    auto r0 = __builtin_amdgcn_permlane32_swap(a0, b0, false, false); auto r1 = __builtin_amdgcn_permlane32_swap(a1, b1, false, false); \
    u32x4 w = {r0[0], r1[0], r0[1], r1[1]}; OUT = *reinterpret_cast<bf16x8*>(&w); } while (0)
  const int NT = seq / KVBLK;
  f32x16 pc, pn; pn = f32x16{};
  bf16x8 q0 = {}, q1 = {}, q2 = {}, q3 = {};
  char* XC0 = XCH;
  KLOAD(0); VLOAD(0); asm volatile("s_waitcnt vmcnt(0)" ::: "memory"); KWRITE(0); VWRITE(0);
  KLOAD(KVBLK); VLOAD(KVBLK); asm volatile("s_waitcnt vmcnt(0)" ::: "memory"); KWRITE(1); VWRITE(1);
  __syncthreads();
  QKH(pc, 0);
  KLOAD((2 < NT ? 2 : NT - 1) * KVBLK);
  __syncthreads();
  for (int j = 0; j < NT; ++j) {
    const int b = j & 1;
    PvT T;
    pv2_issue<2, 3>(T, vb0 + (b ^ 1) * 32768);
    QKH(pn, b ^ 1);
    float ps = 0.f;
#pragma unroll
    for (int r = 0; r < 16; ++r) { pc[r] = __builtin_amdgcn_exp2f(fmaf(pc[r], C, mC)); ps += pc[r]; }
    l_reg += ps;
    pv2_mma(o[2], o[3], T, q0, q1, q2, q3);
    pv2_issue<0, 1>(T, vb0 + (b ^ 1) * 32768);
    bf16x8 own0, own1; PK4(pc, 0, own0); PK4(pc, 8, own1);
    *(bf16x8*)(XC0 + b * 16384 + ((wid * 2 + 0) * 64 + lane) * 16) = own0; *(bf16x8*)(XC0 + b * 16384 + ((wid * 2 + 1) * 64 + lane) * 16) = own1;
    KWRITE(b);
    pv2_mma(o[0], o[1], T, q0, q1, q2, q3);
    __syncthreads();
    VWRITE(b ^ 1);
    { const int kt = (j + 3 < NT) ? j + 3 : NT - 1, vt = (j + 2 < NT) ? j + 2 : NT - 1; KLOAD(kt * KVBLK); VLOAD(vt * KVBLK); }
    q0 = own0; q1 = own1;
    q2 = *(const bf16x8*)(XC0 + b * 16384 + (((wid ^ 4) * 2 + 0) * 64 + lane) * 16); q3 = *(const bf16x8*)(XC0 + b * 16384 + (((wid ^ 4) * 2 + 1) * 64 + lane) * 16);
    pc = pn;
  }
  { PvT T; const int vl = vb0 + ((NT - 1) & 1) * 32768;
    pv2_issue<2, 3>(T, vl); pv2_mma(o[2], o[3], T, q0, q1, q2, q3); pv2_issue<0, 1>(T, vl); pv2_mma(o[0], o[1], T, q0, q1, q2, q3); }
  l_reg += __shfl_xor(l_reg, 32);
  if (hi == 0) LI[kh * 128 + rg * 32 + r32] = l_reg;
  __syncthreads();
  float rli[16];
#pragma unroll
  for (int r = 0; r < 16; ++r) { const int row = rg * 32 + crow(r, hi); rli[r] = __builtin_amdgcn_rcpf(LI[row] + LI[128 + row]); }
  float* Ow = Ob + (long)(rg * 32) * LDO + kh * 128;
#pragma unroll
  for (int r = 0; r < 16; ++r) { const int orow = crow(r, hi);
    for (int d0 = 0; d0 < 4; ++d0) Ow[(long)orow * LDO + d0 * 32 + r32] = o[d0][r] * rli[r]; }
#undef KLOAD
#undef VLOAD
#undef KWRITE
#undef VWRITE
#undef QKH
#undef PK4
}
}
#define XB_TMO      128
#define XB_XCNT(j)  (256  + 64 * (j))
#define XB_XSUB(j)  (1280 + 64 * (j))
#define XB_XGEN(j)  (2304 + 64 * (j))
#define XB_TOP      3328
#define XB_TOPGEN   3392
#define XCD_BAR_WORDS 3456
#define XB_SPIN_CAP (1u << 18)

__device__ __forceinline__ unsigned xb_ld(unsigned* p)              { return __hip_atomic_load(p, __ATOMIC_RELAXED, __HIP_MEMORY_SCOPE_AGENT); }
__device__ __forceinline__ unsigned xb_add(unsigned* p, unsigned v) { return __hip_atomic_fetch_add(p, v, __ATOMIC_RELAXED, __HIP_MEMORY_SCOPE_AGENT); }
__device__ __forceinline__ unsigned xb_xcc_id() { return (unsigned)__builtin_amdgcn_s_getreg((3 << 11) | 20) & 0xFu; }
#define XB_SPIN(cond, bar) do { unsigned _sp = 0; while (cond) { __builtin_amdgcn_s_sleep(1); \
    if ((++_sp & 255u) == 0u) { if (xb_ld(&(bar)[XB_TMO])) break; if (_sp > XB_SPIN_CAP) { atomicAdd(&(bar)[XB_TMO], 1u); break; } } } } while (0)

struct XcdBarrier {
    unsigned* bar; unsigned x;
    volatile LAS unsigned* st;
};

__device__ __forceinline__ XcdBarrier xcd_barrier_post(unsigned* bar, volatile LAS unsigned* st) {
    XcdBarrier b; b.bar = bar; b.x = xb_xcc_id(); b.st = st;
    if (threadIdx.x == 0) (void)xb_add(&bar[XB_XCNT(b.x)], 1u);
    return b;
}
__device__ __forceinline__ void xcd_barrier_complete(unsigned* bar, unsigned x, unsigned& nloc, unsigned& nx) {
    const unsigned G = gridDim.x * gridDim.y * gridDim.z;
    unsigned sum, cnt, mine, sp = 0u;
    for (;;) {
        sum = 0u; cnt = 0u; mine = 0u;
#pragma unroll
        for (unsigned j = 0; j < 16; ++j) { const unsigned c = xb_ld(&bar[XB_XCNT(j)]); sum += c; cnt += (c > 0u) ? 1u : 0u; mine = (j == x) ? c : mine; }
        if (sum == G) break;
        __builtin_amdgcn_s_sleep(1);
        if ((++sp & 255u) == 0u) { if (xb_ld(&bar[XB_TMO])) break; if (sp > XB_SPIN_CAP) { atomicAdd(&bar[XB_TMO], 1u); break; } }
    }
    nloc = mine > 0u ? mine : 1u; nx = cnt > 0u ? cnt : 1u;
}

__device__ __forceinline__ void xcd_barrier(const XcdBarrier& b) {
    asm volatile("s_waitcnt vmcnt(0)" ::: "memory");
    __syncthreads();
    if (threadIdx.x == 0) {
        unsigned* bar = b.bar;
        __builtin_amdgcn_s_waitcnt(0);
        unsigned nloc = b.st[0], nx = b.st[1];
        if (nloc == 0u) { xcd_barrier_complete(bar, b.x, nloc, nx); b.st[0] = nloc; b.st[1] = nx; }
        const unsigned old = xb_add(&bar[XB_XSUB(b.x)], 1u);
        const unsigned gen = old / nloc;
        if (old + 1u == (gen + 1u) * nloc) {
            __builtin_amdgcn_fence(__ATOMIC_RELEASE, "agent");
            asm volatile("s_waitcnt vmcnt(0)" ::: "memory");
            const unsigned og = xb_add(&bar[XB_TOP], 1u);
            const unsigned tg = og / nx;
            if (og + 1u == (tg + 1u) * nx) xb_add(&bar[XB_TOPGEN], 1u);
            else XB_SPIN(xb_ld(&bar[XB_TOPGEN]) == tg, bar);
            __builtin_amdgcn_fence(__ATOMIC_ACQUIRE, "agent");
            xb_add(&bar[XB_XGEN(b.x)], 1u);
            asm volatile("s_waitcnt vmcnt(0)" ::: "memory");
        } else {
            XB_SPIN(xb_ld(&bar[XB_XGEN(b.x)]) == gen, bar);
            __builtin_amdgcn_fence(__ATOMIC_ACQUIRE, "agent");
            asm volatile("s_waitcnt vmcnt(0)" ::: "memory");
        }
    }
    __syncthreads();
}

typedef unsigned short u16;
typedef short s8v __attribute__((ext_vector_type(8)));
typedef float f16v __attribute__((ext_vector_type(16)));
typedef float f4v __attribute__((ext_vector_type(4)));
typedef unsigned u2v __attribute__((ext_vector_type(2)));
constexpr int TL = 8192, TC = 256, TT = TL + TC, DM = 2048, DIN = 8192, PST = 8256;
constexpr int C_AU = 0, C_AV = 512, C_AZ = 1024, C_BQ = 1536, C_BI = 2048, C_BFF = 2560, C_BFB = 3072, C_BZ = 3584, C_CQ = 4096, C_CK = 5120, C_CV = 6144, C_CZ = 7168;
constexpr float EPS = 1e-6f;
constexpr int NCH = 132;
constexpr int CW_KMAX = XCD_BAR_WORDS, CW_SPLIT = CW_KMAX + 64, CTL_WORDS = CW_SPLIT + 4 * 17 * 64;
constexpr size_t WS_WIN = 0, WS_WOUT = WS_WIN + (size_t)4 * 8192 * 2048 * 2, WS_X = WS_WOUT + (size_t)4 * 2048 * 2048 * 2, WS_H = WS_X + (size_t)TT * DM * 4,
                 WS_P = WS_H + (size_t)TT * DM * 2, WS_Y = WS_P + (size_t)TT * PST * 2, WS_AO = WS_Y + (size_t)TT * DM * 2, WS_ST = WS_AO + (size_t)TT * DM * 4,
                 WS_DT = WS_ST + (size_t)2 * NCH * 4 * 16384 * 4, WS_MOD = WS_DT + (size_t)2 * NCH * 4 * 128 * 4, WS_LB = WS_MOD + (size_t)4 * 2 * 6144 * 4,
                 WS_LAM = WS_LB + (size_t)2 * 4 * 512 * 4, WS_CTL = WS_LAM + 256, WS_END = WS_CTL + (size_t)CTL_WORDS * 4;
constexpr int LDS_BYTES = 144 * 1024;
#ifndef PROBE_DUP
#define PROBE_DUP 0
#endif
struct Params { const float* in[18]; float* out; unsigned char* ws; };

__device__ __forceinline__ unsigned f2bf(float f) { unsigned u = __float_as_uint(f); return (u + 0x7fffu + ((u >> 16) & 1u)) >> 16; }
__device__ __forceinline__ unsigned pk2(float lo, float hi) { return f2bf(lo) | (f2bf(hi) << 16); }
__device__ __forceinline__ float bf2f(unsigned h) { return __uint_as_float(h << 16); }
__device__ __forceinline__ float bflo(unsigned w) { return __uint_as_float(w << 16); }
__device__ __forceinline__ float bfhi(unsigned w) { return __uint_as_float(w & 0xffff0000u); }
__device__ __forceinline__ float wave_sum(float v) {
#pragma unroll
    for (int o = 1; o < 64; o <<= 1) v += __shfl_xor(v, o);
    return v;
}
__device__ __forceinline__ int crow(int r, int hi) { return (r & 3) + 8 * (r >> 2) + 4 * hi; }
__device__ __forceinline__ float silu_f(float x) { return x * __builtin_amdgcn_rcpf(1.f + __expf(-x)); }
template <int K> __device__ __forceinline__ void mma32(f16v& acc, const LAS u16* A, int lda, const LAS u16* B, int ldb, int lane) {
    const LAS u16* a = A + (lane & 31) * lda + (lane >> 5) * 8; const LAS u16* b = B + (lane & 31) * ldb + (lane >> 5) * 8;
    s8v av[K / 16], bv[K / 16];
#pragma unroll
    for (int k = 0; k < K / 16; ++k) { av[k] = *(const LAS s8v*)(a + 16 * k); bv[k] = *(const LAS s8v*)(b + 16 * k); }
#pragma unroll
    for (int k = 0; k < K / 16; ++k) acc = __builtin_amdgcn_mfma_f32_32x32x16_bf16(av[k], bv[k], acc, 0, 0, 0);
}
template <int K> __device__ __forceinline__ void mma16(f4v& acc, const LAS u16* A, int lda, const LAS u16* B, int ldb, int lane) {
    const LAS u16* a = A + (lane & 15) * lda + (lane >> 4) * 8; const LAS u16* b = B + (lane & 15) * ldb + (lane >> 4) * 8;
    s8v av[K / 32], bv[K / 32];
#pragma unroll
    for (int k = 0; k < K / 32; ++k) { av[k] = *(const LAS s8v*)(a + 32 * k); bv[k] = *(const LAS s8v*)(b + 32 * k); }
#pragma unroll
    for (int k = 0; k < K / 32; ++k) acc = __builtin_amdgcn_mfma_f32_16x16x32_bf16(av[k], bv[k], acc, 0, 0, 0);
}

__device__ __forceinline__ int win_dest(int n) {
    if (n < C_CQ || n >= C_CV) return n;
    const int j = n & 127, base = n & ~127, a = j >> 6, jj = j & 63, i = jj & 31, half = jj >> 5;
    return base + a * 64 + 2 * i + half;
}
__device__ __forceinline__ void transpose_item(const float* __restrict__ W, int K, int N, u16* __restrict__ WT, LAS float* scr, int item, int lane, bool perm) {
    const int nblk = N / 32, kb = item / nblk, nb = item % nblk, k0 = 64 * kb, n0 = 32 * nb;
    float tv[32];
#pragma unroll
    for (int i = 0; i < 32; ++i) tv[i] = W[(size_t)(k0 + 2 * i + (lane >> 5)) * N + n0 + (lane & 31)];
#pragma unroll
    for (int i = 0; i < 32; ++i) scr[(2 * i + (lane >> 5)) * 33 + (lane & 31)] = tv[i];
    asm volatile("s_waitcnt lgkmcnt(0)" ::: "memory");
    const int c = lane & 7;
#pragma unroll
    for (int j = 0; j < 4; ++j) { const int n = (lane >> 3) + 8 * j; const LAS float* s = scr + (8 * c) * 33 + n;
        uint4 o; o.x = pk2(s[0 * 33], s[1 * 33]); o.y = pk2(s[2 * 33], s[3 * 33]); o.z = pk2(s[4 * 33], s[5 * 33]); o.w = pk2(s[6 * 33], s[7 * 33]);
        const int nd = perm ? win_dest(n0 + n) : (n0 + n);
        *(uint4*)(WT + (size_t)nd * K + k0 + 8 * c) = o; }
    asm volatile("s_waitcnt lgkmcnt(0)" ::: "memory");
}

__device__ __forceinline__ void attn_item(const u16* P, float* AO, const unsigned* kmaxu, int item, char* lds) {
    int hm, qrow0, krow0, seq;
    if (item < 512) { hm = item >> 6; qrow0 = (item & 63) * 128; krow0 = 0; seq = TT; }
    else { hm = (item - 512) >> 1; qrow0 = TL + ((item - 512) & 1) * 128; krow0 = TL; seq = TC; }
    const int h = hm >> 1;
    const att::bf16* Pb = (const att::bf16*)P;
    const att::bf16* Q = Pb + (size_t)qrow0 * PST + C_CQ + hm * 128;
    const att::bf16* K = Pb + (size_t)krow0 * PST + C_CK + hm * 128;
    const att::bf16* V = Pb + (size_t)krow0 * PST + C_CV + h * 256;
    float* O = AO + (size_t)qrow0 * DM + hm * 256;
    const float kmax = sqrtf(__uint_as_float(kmaxu[hm]));
    att::attn_dv256_body(Q, K, V, O, seq, kmax, lds);
}

typedef unsigned u4v __attribute__((ext_vector_type(4)));
struct HgrnT { float bl[16], kk[16]; float r, rtot; };
__device__ __forceinline__ void stage_gates(const uint4 raw, const float4 lb0, const float4 lb1, LAS float* Gs, LAS u16* KKs, int t, int c8) {
    const unsigned w[4] = {raw.x, raw.y, raw.z, raw.w}; const float lb[8] = {lb0.x, lb0.y, lb0.z, lb0.w, lb1.x, lb1.y, lb1.z, lb1.w};
    float g[8], kk[8];
#pragma unroll
    for (int e = 0; e < 8; ++e) { const float a = (e & 1) ? bfhi(w[e >> 1]) : bflo(w[e >> 1]);
        const float sig = __builtin_amdgcn_rcpf(1.f + __expf(-a)); const float f = lb[e] + (1.f - lb[e]) * sig;
        g[e] = fmaxf(__logf(f), -80.f); kk[e] = (1.f - lb[e]) * (1.f - sig); }
    *(LAS f4v*)(Gs + t * 128 + c8) = (f4v){g[0], g[1], g[2], g[3]}; *(LAS f4v*)(Gs + t * 128 + c8 + 4) = (f4v){g[4], g[5], g[6], g[7]};
    *(LAS u4v*)(KKs + t * 128 + c8) = (u4v){pk2(kk[0], kk[1]), pk2(kk[2], kk[3]), pk2(kk[4], kk[5]), pk2(kk[6], kk[7])};
}
__device__ __forceinline__ void hgrn_read(HgrnT& G, const LAS float* Gs, const LAS u16* KKs, int dir, int k, int Is, LAS float* tot) {
    float run = 0.f;
#pragma unroll
    for (int js = 0; js < 16; ++js) { const int t = dir ? 63 - (16 * Is + js) : 16 * Is + js;
        run += Gs[t * 128 + k]; G.bl[js] = run; G.kk[js] = bf2f(KKs[t * 128 + k]); }
    tot[Is * 128 + k] = run;
}
__device__ __forceinline__ void hgrn_prefix(HgrnT& G, int k, int Is, const LAS float* tot) {
    float r = 0.f, rt = 0.f;
#pragma unroll
    for (int i = 0; i < 4; ++i) { const float v = tot[i * 128 + k]; rt += v; if (i < Is) r += v; }
    G.r = r; G.rtot = rt;
}
__device__ __forceinline__ void store_vt(const uint4 w, LAS u16* Vt, int t, int c8) {
    const unsigned ww[4] = {w.x, w.y, w.z, w.w};
#pragma unroll
    for (int e = 0; e < 4; ++e) { Vt[(c8 + 2 * e) * 72 + t] = (u16)(ww[e] & 0xffffu); Vt[(c8 + 2 * e + 1) * 72 + t] = (u16)(ww[e] >> 16); }
}
__device__ __forceinline__ int scan_index(int dir, int rc) { return dir ? (rc < 128 ? 4 + 127 - rc : 3 - (rc - 128)) : (rc < 128 ? 4 + rc : rc - 128); }

__device__ __forceinline__ void hgrn_a_item(const u16* P, const float* LBl0, const float* LBl1, float* ST, float* DT, int rc, int h, LAS unsigned char* L, int tid) {
    const int lane = tid & 63, w = tid >> 6, k = tid & 127, Is = tid >> 7;
    const int R0 = rc < 128 ? 64 * rc : TL + 64 * (rc - 128);
    LAS u16* Vt = (LAS u16*)L; LAS u16* Kd = (LAS u16*)(L + 18432); LAS float* tot = (LAS float*)(L + 36864);
    LAS float* Gs = (LAS float*)(L + 40960); LAS u16* KKs = (LAS u16*)(L + 73728);
    uint4 raf[2], rab[2], rv[2]; float4 lbf[2][2], lbb[2][2];
#pragma unroll
    for (int i = 0; i < 2; ++i) { const int idx = tid + 512 * i, t = idx >> 4, c8 = (idx & 15) * 8; const u16* base = P + (size_t)(R0 + t) * PST + h * 128 + c8;
        raf[i] = *(const uint4*)(base + C_BFF); rab[i] = *(const uint4*)(base + C_BFB); rv[i] = *(const uint4*)(base + C_BI);
        lbf[i][0] = *(const float4*)(LBl0 + h * 128 + c8); lbf[i][1] = *(const float4*)(LBl0 + h * 128 + c8 + 4);
        lbb[i][0] = *(const float4*)(LBl1 + h * 128 + c8); lbb[i][1] = *(const float4*)(LBl1 + h * 128 + c8 + 4); }
#pragma unroll
    for (int i = 0; i < 2; ++i) { const int idx = tid + 512 * i; store_vt(rv[i], Vt, idx >> 4, (idx & 15) * 8); }
    for (int dir = 0; dir < 2; ++dir) {
#pragma unroll
        for (int i = 0; i < 2; ++i) { const int idx = tid + 512 * i; stage_gates(dir ? rab[i] : raf[i], dir ? lbb[i][0] : lbf[i][0], dir ? lbb[i][1] : lbf[i][1], Gs, KKs, idx >> 4, (idx & 15) * 8); }
        __syncthreads();
        HgrnT G; hgrn_read(G, Gs, KKs, dir, k, Is, tot);
        __syncthreads();
        hgrn_prefix(G, k, Is, tot);
        const int n = scan_index(dir, rc);
#pragma unroll
        for (int js = 0; js < 16; ++js) { const int t = dir ? 63 - (16 * Is + js) : 16 * Is + js;
            Kd[k * 72 + t] = (u16)f2bf(G.kk[js] * __expf(G.rtot - G.r - G.bl[js])); }
        if (Is == 0) DT[((size_t)(dir * NCH + n) * 4 + h) * 128 + k] = __expf(G.rtot);
        __syncthreads();
        const int mt = w >> 1;
        float* Ug = ST + ((size_t)(dir * NCH + n) * 4 + h) * 16384;
#pragma unroll
        for (int j = 0; j < 2; ++j) { const int nt = (w & 1) * 2 + j; f16v acc = {};
            mma32<64>(acc, Vt + 32 * mt * 72, 72, Kd + 32 * nt * 72, 72, lane);
#pragma unroll
            for (int r = 0; r < 16; ++r) Ug[(32 * mt + crow(r, lane >> 5)) * 128 + 32 * nt + (lane & 31)] = acc[r]; }
        __syncthreads();
    }
}
__device__ __forceinline__ void hgrn_c_item(const u16* P, const float* LBl0, const float* LBl1, const float* ST, const float* hnw, u16* Y, int rc, int h, LAS unsigned char* L, int tid) {
    const int lane = tid & 63, w = tid >> 6, k = tid & 127, Is = tid >> 7;
    const int R0 = rc < 128 ? 64 * rc : TL + 64 * (rc - 128);
    LAS u16* Qt = (LAS u16*)L; LAS u16* Qh = (LAS u16*)(L + 17408); LAS u16* Kt = (LAS u16*)(L + 34816); LAS u16* Vt = (LAS u16*)(L + 78336);
    LAS u16* Am = (LAS u16*)(L + 96768); LAS u16* Sb = (LAS u16*)(L + 105984); LAS float* tot = (LAS float*)(L + 140800);
    LAS float* Gs = (LAS float*)L; LAS u16* KKs = (LAS u16*)(L + 32768); LAS u16* Qs = (LAS u16*)(L + 49152);
    uint4 raf[2], rab[2], rq[2], rv[2]; float4 lbf[2][2], lbb[2][2]; float4 sreg[8];
#pragma unroll
    for (int i = 0; i < 2; ++i) { const int idx = tid + 512 * i, t = idx >> 4, c8 = (idx & 15) * 8; const u16* base = P + (size_t)(R0 + t) * PST + h * 128 + c8;
        raf[i] = *(const uint4*)(base + C_BFF); rab[i] = *(const uint4*)(base + C_BFB); rq[i] = *(const uint4*)(base + C_BQ); rv[i] = *(const uint4*)(base + C_BI);
        lbf[i][0] = *(const float4*)(LBl0 + h * 128 + c8); lbf[i][1] = *(const float4*)(LBl0 + h * 128 + c8 + 4);
        lbb[i][0] = *(const float4*)(LBl1 + h * 128 + c8); lbb[i][1] = *(const float4*)(LBl1 + h * 128 + c8 + 4); }
    { const float* Sg = ST + ((size_t)(0 * NCH + scan_index(0, rc)) * 4 + h) * 16384;
#pragma unroll
      for (int i = 0; i < 8; ++i) { const int idx = tid + 512 * i; sreg[i] = *(const float4*)(Sg + (idx >> 5) * 128 + (idx & 31) * 4); } }
    const int te = tid >> 3, c0 = (tid & 7) * 16;
    const uint4 z0 = *(const uint4*)(P + (size_t)(R0 + te) * PST + C_BZ + h * 128 + c0), z1 = *(const uint4*)(P + (size_t)(R0 + te) * PST + C_BZ + h * 128 + c0 + 8);
#pragma unroll
    for (int i = 0; i < 2; ++i) { const int idx = tid + 512 * i; store_vt(rv[i], Vt, idx >> 4, (idx & 15) * 8); }
    f16v acc = {};
    const int mt = w >> 2, nt = w & 3;
    for (int dir = 0; dir < 2; ++dir) {
#pragma unroll
        for (int i = 0; i < 8; ++i) { const int idx = tid + 512 * i, v = idx >> 5, k4 = (idx & 31) * 4;
            *(LAS u2v*)(Sb + v * 136 + k4) = (u2v){pk2(sreg[i].x, sreg[i].y), pk2(sreg[i].z, sreg[i].w)}; }
        if (dir == 0) { const float* Sg = ST + ((size_t)(1 * NCH + scan_index(1, rc)) * 4 + h) * 16384;
#pragma unroll
            for (int i = 0; i < 8; ++i) { const int idx = tid + 512 * i; sreg[i] = *(const float4*)(Sg + (idx >> 5) * 128 + (idx & 31) * 4); } }
#pragma unroll
        for (int i = 0; i < 2; ++i) { const int idx = tid + 512 * i, t = idx >> 4, c8 = (idx & 15) * 8;
            stage_gates(dir ? rab[i] : raf[i], dir ? lbb[i][0] : lbf[i][0], dir ? lbb[i][1] : lbf[i][1], Gs, KKs, t, c8);
            *(LAS u4v*)(Qs + t * 128 + c8) = (u4v){rq[i].x, rq[i].y, rq[i].z, rq[i].w}; }
        __syncthreads();
        HgrnT G; hgrn_read(G, Gs, KKs, dir, k, Is, tot);
        float qv[16];
#pragma unroll
        for (int js = 0; js < 16; ++js) { const int t = dir ? 63 - (16 * Is + js) : 16 * Is + js; qv[js] = bf2f(Qs[t * 128 + k]); }
        __syncthreads();
        hgrn_prefix(G, k, Is, tot);
        float rI[4];
        { float run = 0.f;
#pragma unroll
          for (int i = 0; i < 4; ++i) { rI[i] = run - G.r; run += tot[i * 128 + k]; } }
        const float er = __expf(G.r);
#pragma unroll
        for (int js = 0; js < 16; ++js) { const int t = dir ? 63 - (16 * Is + js) : 16 * Is + js;
            const float q = qv[js]; const float e1 = __expf(G.bl[js]);
            Qt[t * 136 + k] = (u16)f2bf(q * e1); Qh[t * 136 + k] = (u16)f2bf(q * e1 * er);
#pragma unroll
            for (int Ip = 0; Ip < 4; ++Ip) if (Ip >= Is) {
                const float ex = fminf(rI[Ip] - G.bl[js], 60.f);
                Kt[(8 * Ip * (Ip + 1) + 16 * Is + (t & 15)) * 136 + k] = (u16)f2bf(G.kk[js] * __expf(ex)); } }
        __syncthreads();
#pragma unroll
        for (int j = 0; j < 2; ++j) { const int id = w * 2 + j, Ir = id >> 2, Js = id & 3; const int It = dir ? 3 - Ir : Ir, Jt = dir ? 3 - Js : Js;
            f4v sc = {0.f, 0.f, 0.f, 0.f};
            if (Js <= Ir) mma16<128>(sc, Qt + 16 * It * 136, 136, Kt + (8 * Ir * (Ir + 1) + 16 * Js) * 136, 136, lane);
#pragma unroll
            for (int i = 0; i < 4; ++i) { const int t = 16 * It + 4 * (lane >> 4) + i, tp = 16 * Jt + (lane & 15);
                float v = sc[i]; if (Js > Ir) v = 0.f; else if (Js == Ir) { if (dir ? (tp < t) : (tp > t)) v = 0.f; }
                Am[t * 72 + tp] = (u16)f2bf(v); } }
        __syncthreads();
        mma32<128>(acc, Qh + 32 * mt * 136, 136, Sb + 32 * nt * 136, 136, lane);
        mma32<64>(acc, Am + 32 * mt * 72, 72, Vt + 32 * nt * 72, 72, lane);
        __syncthreads();
    }
    LAS float* Ob = (LAS float*)L;
#pragma unroll
    for (int r = 0; r < 16; ++r) Ob[(32 * mt + crow(r, lane >> 5)) * 132 + 32 * nt + (lane & 31)] = acc[r];
    __syncthreads();
    { float o[16]; float ss = 0.f;
#pragma unroll
      for (int i = 0; i < 16; ++i) { o[i] = Ob[te * 132 + c0 + i]; ss += o[i] * o[i]; }
      ss += __shfl_xor(ss, 1); ss += __shfl_xor(ss, 2); ss += __shfl_xor(ss, 4);
      const float rs = rsqrtf(ss * (1.f / 128.f) + EPS);
      u16* yp = Y + (size_t)(R0 + te) * DM + 512 + h * 128 + c0;
      const unsigned zz[8] = {z0.x, z0.y, z0.z, z0.w, z1.x, z1.y, z1.z, z1.w};
      unsigned ow[8];
#pragma unroll
      for (int i = 0; i < 8; ++i) { const float y0 = o[2 * i] * rs * hnw[c0 + 2 * i] * bflo(zz[i]), y1 = o[2 * i + 1] * rs * hnw[c0 + 2 * i + 1] * bfhi(zz[i]); ow[i] = pk2(y0, y1); }
      *(uint4*)yp = make_uint4(ow[0], ow[1], ow[2], ow[3]); *(uint4*)(yp + 8) = make_uint4(ow[4], ow[5], ow[6], ow[7]); }
    __syncthreads();
}

__device__ __forceinline__ void gmlp_item(const u16* P, const float* lnw, const float* lnb, const float* wsl  , const float* bsl  , u16* Y, int c, int h, LAS unsigned char* L, int tid) {
    const int lane = tid & 63, w = tid >> 6;
    const int R0 = c < 64 ? 128 * c : TL + 128 * (c - 64);
    LAS u16* Wb = (LAS u16*)L; LAS u16* Vb = (LAS u16*)(L + 34816); LAS float* mean = (LAS float*)(L + 69632); LAS float* rstd = mean + 128;
    float4 wreg[8]; uint4 srow[16], vch[4], uu[4], zz[4];
    { const float* wg = wsl + (size_t)h * 16384;
#pragma unroll
      for (int i = 0; i < 8; ++i) { const int idx = tid + 512 * i; wreg[i] = *(const float4*)(wg + (idx >> 5) * 128 + (idx & 31) * 4); } }
#pragma unroll
    for (int rr = 0; rr < 16; ++rr) srow[rr] = *(const uint4*)(P + (size_t)(R0 + 16 * w + rr) * PST + C_AV + lane * 8);
#pragma unroll
    for (int i = 0; i < 4; ++i) { const int idx = tid + 512 * i; vch[i] = *(const uint4*)(P + (size_t)(R0 + (idx >> 4)) * PST + C_AV + h * 128 + (idx & 15) * 8); }
    const int te = tid >> 2, ce = (tid & 3) * 32;
#pragma unroll
    for (int i = 0; i < 4; ++i) { uu[i] = *(const uint4*)(P + (size_t)(R0 + te) * PST + C_AU + h * 128 + ce + 8 * i); zz[i] = *(const uint4*)(P + (size_t)(R0 + te) * PST + C_AZ + h * 128 + ce + 8 * i); }
#pragma unroll
    for (int rr = 0; rr < 16; ++rr) { const int t = 16 * w + rr; const uint4 wv = srow[rr];
        float x[8] = {bflo(wv.x), bfhi(wv.x), bflo(wv.y), bfhi(wv.y), bflo(wv.z), bfhi(wv.z), bflo(wv.w), bfhi(wv.w)};
        float s = 0.f;
#pragma unroll
        for (int i = 0; i < 8; ++i) s += x[i];
        const float mu = wave_sum(s) * (1.f / 512.f); float s2 = 0.f;
#pragma unroll
        for (int i = 0; i < 8; ++i) { const float d = x[i] - mu; s2 += d * d; }
        const float var = wave_sum(s2) * (1.f / 512.f);
        if (lane == 0) { mean[t] = mu; rstd[t] = rsqrtf(var + EPS); } }
#pragma unroll
    for (int i = 0; i < 8; ++i) { const int idx = tid + 512 * i, t = idx >> 5, s4 = (idx & 31) * 4;
        *(LAS u2v*)(Wb + t * 136 + s4) = (u2v){pk2(wreg[i].x, wreg[i].y), pk2(wreg[i].z, wreg[i].w)}; }
    __syncthreads();
#pragma unroll
    for (int i = 0; i < 4; ++i) { const int idx = tid + 512 * i, s = idx >> 4, d8 = (idx & 15) * 8; const uint4 wv = vch[i];
        const float x[8] = {bflo(wv.x), bfhi(wv.x), bflo(wv.y), bfhi(wv.y), bflo(wv.z), bfhi(wv.z), bflo(wv.w), bfhi(wv.w)};
        const float mu = mean[s], rs = rstd[s];
#pragma unroll
        for (int e = 0; e < 8; ++e) { const int d = h * 128 + d8 + e; Vb[(d8 + e) * 136 + s] = (u16)f2bf((x[e] - mu) * rs * lnw[d] + lnb[d]); } }
    __syncthreads();
    const int mt = w >> 1;
    f16v acc0 = {}, acc1 = {};
    mma32<128>(acc0, Wb + 32 * mt * 136, 136, Vb + 32 * ((w & 1) * 2) * 136, 136, lane);
    mma32<128>(acc1, Wb + 32 * mt * 136, 136, Vb + 32 * ((w & 1) * 2 + 1) * 136, 136, lane);
    __syncthreads();
    LAS float* Ob = (LAS float*)L;
#pragma unroll
    for (int r = 0; r < 16; ++r) { const int t = 32 * mt + crow(r, lane >> 5);
        Ob[t * 132 + 32 * ((w & 1) * 2) + (lane & 31)] = acc0[r]; Ob[t * 132 + 32 * ((w & 1) * 2 + 1) + (lane & 31)] = acc1[r]; }
    __syncthreads();
    { const float bsv = bsl[h * 128 + te]; u16* yp = Y + (size_t)(R0 + te) * DM + h * 128 + ce;
#pragma unroll
      for (int i = 0; i < 4; ++i) { const unsigned uw[4] = {uu[i].x, uu[i].y, uu[i].z, uu[i].w}, zw[4] = {zz[i].x, zz[i].y, zz[i].z, zz[i].w}; unsigned ow[4];
#pragma unroll
          for (int e = 0; e < 4; ++e) { const float s0 = Ob[te * 132 + ce + 8 * i + 2 * e] + bsv, s1 = Ob[te * 132 + ce + 8 * i + 2 * e + 1] + bsv;
              ow[e] = pk2(bflo(uw[e]) * s0 * bflo(zw[e]), bfhi(uw[e]) * s1 * bfhi(zw[e])); }
          *(uint4*)(yp + 8 * i) = make_uint4(ow[0], ow[1], ow[2], ow[3]); } }
    __syncthreads();
}

__device__ __forceinline__ void ctx_out_tile(const u16* Y, const u16* WT, const float* Xcin, float* X, const float* gate_c, int tile, LAS unsigned char* L, int tid) {
    const int lane = tid & 63, w = tid >> 6, mt = w & 1, ks = w >> 1;
    const int r0 = (tile >> 6) * 64, n0 = (tile & 63) * 32;
    f16v acc = {};
    LAS u16* As = (LAS u16*)L; LAS u16* Bs = (LAS u16*)(L + 33792);
    const u16* ag = Y + (size_t)(TL + r0) * DM; const u16* bg = WT + (size_t)n0 * DM;
    uint4 ra[4], rb[2];
#pragma unroll
    for (int i = 0; i < 4; ++i) { const int idx = tid + 512 * i; ra[i] = *(const uint4*)(ag + (size_t)(idx >> 5) * DM + (idx & 31) * 8); }
#pragma unroll
    for (int i = 0; i < 2; ++i) { const int idx = tid + 512 * i; rb[i] = *(const uint4*)(bg + (size_t)(idx >> 5) * DM + (idx & 31) * 8); }
    for (int kc = 0; kc < 8; ++kc) {
#pragma unroll
        for (int i = 0; i < 4; ++i) { const int idx = tid + 512 * i; *(LAS u4v*)(As + (idx >> 5) * 264 + (idx & 31) * 8) = (u4v){ra[i].x, ra[i].y, ra[i].z, ra[i].w}; }
#pragma unroll
        for (int i = 0; i < 2; ++i) { const int idx = tid + 512 * i; *(LAS u4v*)(Bs + (idx >> 5) * 264 + (idx & 31) * 8) = (u4v){rb[i].x, rb[i].y, rb[i].z, rb[i].w}; }
        __syncthreads();
        if (kc < 7) {
#pragma unroll
            for (int i = 0; i < 4; ++i) { const int idx = tid + 512 * i; ra[i] = *(const uint4*)(ag + (size_t)(idx >> 5) * DM + (kc + 1) * 256 + (idx & 31) * 8); }
#pragma unroll
            for (int i = 0; i < 2; ++i) { const int idx = tid + 512 * i; rb[i] = *(const uint4*)(bg + (size_t)(idx >> 5) * DM + (kc + 1) * 256 + (idx & 31) * 8); } }
        mma32<64>(acc, As + 32 * mt * 264 + ks * 64, 264, Bs + ks * 64, 264, lane);
        __syncthreads();
    }
    LAS float* red = (LAS float*)L;
#pragma unroll
    for (int r = 0; r < 16; ++r) red[(w * 16 + r) * 64 + lane] = acc[r];
    __syncthreads();
    if (w < 2) { float xc[16], gc;
        gc = gate_c[n0 + (lane & 31)];
#pragma unroll
        for (int r = 0; r < 16; ++r) xc[r] = Xcin[(size_t)(r0 + 32 * w + crow(r, lane >> 5)) * DM + n0 + (lane & 31)];
        asm volatile("" ::: "memory");
#pragma unroll
        for (int r = 0; r < 16; ++r) { float s = 0.f;
#pragma unroll
            for (int q = 0; q < 4; ++q) s += red[((q * 2 + w) * 16 + r) * 64 + lane];
            const int row = TL + r0 + 32 * w + crow(r, lane >> 5), col = n0 + (lane & 31);
            X[(size_t)row * DM + col] = xc[r] + gc * s; } }
    __syncthreads();
}

__device__ __forceinline__ void split_arrive(unsigned* w  , unsigned xcc, unsigned nloc, int tid) {
    asm volatile("s_waitcnt vmcnt(0)" ::: "memory");
    __syncthreads();
    if (tid == 0) {
        const unsigned old = xb_add(&w[64 * xcc], 1u);
        if (old + 1u == nloc) { __builtin_amdgcn_fence(__ATOMIC_RELEASE, "agent"); asm volatile("s_waitcnt vmcnt(0)" ::: "memory"); (void)xb_add(&w[64 * 16], 1u); }
    }
}
__device__ __forceinline__ void split_wait(unsigned* w, unsigned nx, int tid) {
    if (tid == 0) { unsigned sp = 0; while (xb_ld(&w[64 * 16]) < nx) { __builtin_amdgcn_s_sleep(1); if (++sp > (1u << 22)) break; }
        __builtin_amdgcn_fence(__ATOMIC_ACQUIRE, "agent"); asm volatile("s_waitcnt vmcnt(0)" ::: "memory"); }
    __syncthreads();
}

__global__ void __launch_bounds__(512, 2) mega(Params p) {
    extern __shared__ __attribute__((aligned(16))) unsigned char lds[];
    cg::grid_group grid = cg::this_grid();
    LAS unsigned char* L = (LAS unsigned char*)lds;
    int tid = tidx(), lane = tid & 63, wave = tid >> 6; const int bid = blockIdx.x, G = gridDim.x;
    int gw = bid * 8 + wave; const int ngw = G * 8;
#define RETID() do { tid = tidx(); lane = tid & 63; wave = tid >> 6; gw = bid * 8 + wave; } while (0)
    unsigned char* ws = p.ws;
    volatile LAS unsigned* bst = (volatile LAS unsigned*)(L + LDS_BYTES - 16);
    if (tid < 4) bst[tid] = 0u;
    __syncthreads();
    XcdBarrier xbar = xcd_barrier_post((unsigned*)(ws + WS_CTL), bst);
#define GSYNC() xcd_barrier(xbar)
    u16* WIN = (u16*)(ws + WS_WIN); u16* WOUT = (u16*)(ws + WS_WOUT); float* X = (float*)(ws + WS_X); u16* H = (u16*)(ws + WS_H);
    u16* P = (u16*)(ws + WS_P); u16* Y = (u16*)(ws + WS_Y); float* AO = (float*)(ws + WS_AO); float* ST = (float*)(ws + WS_ST); float* DT = (float*)(ws + WS_DT);
    float* MOD = (float*)(ws + WS_MOD); float* LB = (float*)(ws + WS_LB); float* LAM = (float*)(ws + WS_LAM);

for (int rep_ = 0; rep_ < (PROBE_DUP == 7 ? 2 : 1); ++rep_) {
    { LAS float* scr = (LAS float*)(L + wave * 8448);
      for (int it = gw; it < 40960; it += ngw) {
          if (it < 32768) { const int l = it >> 13; transpose_item(p.in[7] + (size_t)l * 2048 * 8192, 2048, 8192, WIN + (size_t)l * 8192 * 2048, scr, it & 8191, lane, true); }
          else { const int r = it - 32768, l = r >> 11; transpose_item(p.in[16] + (size_t)l * 2048 * 2048, 2048, 2048, WOUT + (size_t)l * 2048 * 2048, scr, r & 2047, lane, false); } }
      __syncthreads();
      LAS float* red = (LAS float*)L;
      for (int it = bid; it < 768; it += G) { const int l = it / 192, col0 = (it % 192) * 32;
          const int c4 = tid & 7, kp = tid >> 3;
          const float* wp = p.in[4] + (size_t)l * 2048 * 6144 + col0 + c4 * 4;
          float4 a = {0.f, 0.f, 0.f, 0.f}, b = {0.f, 0.f, 0.f, 0.f};
#pragma unroll 16
          for (int kk = 0; kk < 32; ++kk) { const int k = 32 * kp + kk; const float sa = silu_f(p.in[1][k]), sb = silu_f(p.in[3][k]);
              const float4 wv = *(const float4*)(wp + (size_t)k * 6144);
              a.x += sa * wv.x; a.y += sa * wv.y; a.z += sa * wv.z; a.w += sa * wv.w; b.x += sb * wv.x; b.y += sb * wv.y; b.z += sb * wv.z; b.w += sb * wv.w; }
          LAS float* rp = red + (kp * 8 + c4) * 8;
          rp[0] = a.x; rp[1] = a.y; rp[2] = a.z; rp[3] = a.w; rp[4] = b.x; rp[5] = b.y; rp[6] = b.z; rp[7] = b.w;
          __syncthreads();
          if (tid < 64) { const int col = tid & 31, src = tid >> 5; float s = 0.f;
              for (int q = 0; q < 64; ++q) s += red[(q * 8 + (col >> 2)) * 8 + src * 4 + (col & 3)];
              MOD[((size_t)l * 2 + src) * 6144 + col0 + col] = s + p.in[5][(size_t)l * 6144 + col0 + col]; }
          __syncthreads(); }
      if (bid == G - 1) {
          for (int i = tid; i < 1024; i += 512) { const int d = i >> 9, c = i & 511; const float* lbp = p.in[12] + (size_t)d * 4 * 512 + c;
              const float v0 = lbp[0], v1 = lbp[512], v2 = lbp[1024], v3 = lbp[1536]; const float mx = fmaxf(fmaxf(v0, v1), fmaxf(v2, v3));
              const float e0 = __expf(v0 - mx), e1 = __expf(v1 - mx), e2 = __expf(v2 - mx), e3 = __expf(v3 - mx), inv = 1.f / (e0 + e1 + e2 + e3);
              float* o = LB + (size_t)d * 4 * 512 + c; o[0] = 0.f; o[512] = e1 * inv; o[1024] = (e1 + e2) * inv; o[1536] = (e1 + e2 + e3) * inv; }
          if (wave < 4) { const float* lp = p.in[14] + (size_t)wave * 4 * 128;
              const float s1 = wave_sum(lp[lane] * lp[128 + lane] + lp[64 + lane] * lp[128 + 64 + lane]);
              const float s2 = wave_sum(lp[256 + lane] * lp[384 + lane] + lp[256 + 64 + lane] * lp[384 + 64 + lane]);
              const float li = 0.8f - 0.6f * expf(-0.3f * (float)wave);
              if (lane == 0) { LAM[wave] = expf(s1) - expf(s2) + li; LAM[4 + wave] = li; } } }
    }
    grid.sync();

}

    if (PROBE_DUP == 8) { for (int q_ = 0; q_ < 20; ++q_) GSYNC(); }
    for (int l = 0; l < 4; ++l) {
        const float* mod = MOD + (size_t)l * 2 * 6144;
for (int rep_ = 0; rep_ < (PROBE_DUP == 1 ? 2 : 1); ++rep_) {
        RETID();
        { const float* nw = p.in[6] + (size_t)l * DM;
          for (int row = gw; row < TT; row += ngw) {
              const float4* xr = (const float4*)(l == 0 ? (row < TL ? p.in[0] + (size_t)row * DM : p.in[2] + (size_t)(row - TL) * DM) : X + (size_t)row * DM) + lane; float4 v[8]; float ss = 0.f;
#pragma unroll
              for (int j = 0; j < 8; ++j) { v[j] = xr[64 * j]; ss += v[j].x * v[j].x + v[j].y * v[j].y + v[j].z * v[j].z + v[j].w * v[j].w; }
              const float r = rsqrtf(wave_sum(ss) * (1.f / DM) + EPS);
              const float* md = mod + (row >= TL ? 6144 : 0);
              uint2* hp = (uint2*)(H + (size_t)row * DM) + lane;
#pragma unroll
              for (int j = 0; j < 8; ++j) { const int col = 4 * (lane + 64 * j); const float4 w4 = *(const float4*)(nw + col), sc = *(const float4*)(md + 2048 + col), sh = *(const float4*)(md + col);
                  uint2 o; o.x = pk2(v[j].x * r * w4.x * (1.f + sc.x) + sh.x, v[j].y * r * w4.y * (1.f + sc.y) + sh.y);
                  o.y = pk2(v[j].z * r * w4.z * (1.f + sc.z) + sh.z, v[j].w * r * w4.w * (1.f + sc.w) + sh.w); hp[64 * j] = o; } } }
        GSYNC();

}
        { pg8::Gemm g{H, WIN + (size_t)l * 8192 * 2048, TT, DIN, DM}; pg8::MainOrder S; S.init(TL, DIN, G, bid);
          pg8::EpiProj E{P};
          pg8::gemm_phase<pg8::EpiProj, pg8::MainOrder, true, true>(L, g, S, E); }
        RETID();
        { unsigned* sw_ = (unsigned*)(ws + WS_CTL) + CW_SPLIT + l * 17 * 64;
          split_arrive(sw_, xbar.x, bst[0], tid);
          if (bid < 32) { pg8::Gemm g{H, WIN + (size_t)l * 8192 * 2048, TT, DIN, DM}; pg8::TailOrder S{bid}; pg8::EpiProj E{P};
              pg8::gemm_phase<pg8::EpiProj, pg8::TailOrder, true, true>(L, g, S, E); }
          else { split_wait(sw_, bst[1], tid);
              const float* LB0 = LB + (size_t)l * 512; const float* LB1 = LB + (size_t)(4 + l) * 512;
              for (int it = bid - 32; it < 264 + 528; it += G - 32) { RETID();
                  if (it < 264) gmlp_item(P, p.in[8] + (size_t)l * 512, p.in[9] + (size_t)l * 512, p.in[10] + (size_t)l * 4 * 16384, p.in[11] + (size_t)l * 512, Y, it >> 2, it & 3, L, tid);
                  else { const int r = it - 264; hgrn_a_item(P, LB0, LB1, ST, DT, r >> 2, r & 3, L, tid); } } } }
        GSYNC();
        RETID();
        { float mx = 0.f;
          for (int row = gw; row < TT; row += ngw) { const u16* kp = P + (size_t)row * PST + C_CK + lane * 16;
              const uint4 a = *(const uint4*)kp, b2 = *(const uint4*)(kp + 8); const unsigned ww[8] = {a.x, a.y, a.z, a.w, b2.x, b2.y, b2.z, b2.w}; float ss = 0.f;
#pragma unroll
              for (int e = 0; e < 8; ++e) { const float x0 = bflo(ww[e]), x1 = bfhi(ww[e]); ss += x0 * x0 + x1 * x1; }
              ss += __shfl_xor(ss, 1); ss += __shfl_xor(ss, 2); ss += __shfl_xor(ss, 4); mx = fmaxf(mx, ss); }
          if ((lane & 7) == 0) atomicMax((unsigned*)(ws + WS_CTL) + CW_KMAX + l * 8 + (lane >> 3), __float_as_uint(mx)); }
        for (int gid = bid * 512 + tid; gid < 131072; gid += G * 512) {
            const int k = gid & 127, v = (gid >> 7) & 127, h = (gid >> 14) & 3, dir = gid >> 16;
            float S = 0.f;
            float* sp = ST + ((size_t)(dir * NCH) * 4 + h) * 16384 + v * 128 + k; const float* dp = DT + ((size_t)(dir * NCH) * 4 + h) * 128 + k;
            float u[12], d[12], un[12], dn[12];
#pragma unroll
            for (int j = 0; j < 12; ++j) { u[j] = sp[(size_t)j * 65536]; d[j] = dp[(size_t)j * 512]; }
            for (int b = 0; b < NCH / 12; ++b) { const int n0 = 12 * b;
                if (b + 1 < NCH / 12) {
#pragma unroll
                    for (int j = 0; j < 12; ++j) { un[j] = sp[(size_t)(n0 + 12 + j) * 65536]; dn[j] = dp[(size_t)(n0 + 12 + j) * 512]; } }
#pragma unroll
                for (int j = 0; j < 12; ++j) { sp[(size_t)(n0 + j) * 65536] = S; S = d[j] * S + u[j]; }
#pragma unroll
                for (int j = 0; j < 12; ++j) { u[j] = un[j]; d[j] = dn[j]; } } }
        GSYNC();
for (int rep_ = 0; rep_ < ((PROBE_DUP == 4 || PROBE_DUP == 5) ? 2 : 1); ++rep_) {
        RETID();
        { const float* LB0 = LB + (size_t)l * 512; const float* LB1 = LB + (size_t)(4 + l) * 512;
          const int natt = (l < 3) ? 528 : 512;
          for (int it = bid; it < 528 + ((G >= 32) ? 512 : 528); it += G) { RETID();
              if (it < 528) { if (it < natt && !(PROBE_DUP == 5 && rep_ == 1)) {
                  int item = it;
                  if (it < 512 && G == 256) { const int rnd = it >> 8, wg = it & 255; item = ((wg & 7) << 6) | (rnd * 32 + (wg >> 3)); }
                  attn_item(P, AO, (const unsigned*)(ws + WS_CTL) + CW_KMAX + l * 8, item, (char*)lds); __syncthreads(); } }
              else { const int r = it - 528; hgrn_c_item(P, LB0, LB1, ST, p.in[13] + (size_t)l * 128, Y, r >> 2, r & 3, L, tid); } } }
        GSYNC();

}
for (int rep_ = 0; rep_ < (PROBE_DUP == 6 ? 2 : 1); ++rep_) {
        RETID();
        { const float lam = LAM[l], li1 = 1.f - LAM[4 + l]; const float* sw = p.in[15] + (size_t)l * 256;
          const int nrow = (l < 3) ? TT : TL;
          const bool side = (l < 3) && (G >= 32);
          const int apn = side ? (G - 16) * 8 : ngw;
          if (side && bid >= G - 16) { RETID(); const int r = 512 + (bid - (G - 16)); hgrn_c_item(P, LB + (size_t)l * 512, LB + (size_t)(4 + l) * 512, ST, p.in[13] + (size_t)l * 128, Y, r >> 2, r & 3, L, tid); }
          else
          { const float4 s4 = *(const float4*)(sw + lane * 4); const int vh = lane >> 5, e = (lane & 31) * 4, lim = nrow * 4;
            for (int it0 = gw; it0 < lim; it0 += 4 * apn) {
                float4 o0[4], o1[4]; uint2 zw[4];
#pragma unroll
                for (int q = 0; q < 4; ++q) { const int it = it0 + q * apn; const int itc = it < lim ? it : it0; const int row = itc >> 2, h = itc & 3;
                    o0[q] = *(const float4*)(AO + (size_t)row * DM + (h * 4 + vh) * 128 + e); o1[q] = *(const float4*)(AO + (size_t)row * DM + (h * 4 + 2 + vh) * 128 + e);
                    zw[q] = *(const uint2*)(P + (size_t)row * PST + C_CZ + h * 256 + lane * 4); }
                asm volatile("" ::: "memory");
#pragma unroll
                for (int q = 0; q < 4; ++q) { const int it = it0 + q * apn; const int row = it >> 2, h = it & 3;
                    const float d0 = o0[q].x - lam * o1[q].x, d1 = o0[q].y - lam * o1[q].y, d2 = o0[q].z - lam * o1[q].z, d3 = o0[q].w - lam * o1[q].w;
                    const float rs = rsqrtf(wave_sum(d0 * d0 + d1 * d1 + d2 * d2 + d3 * d3) * (1.f / 256.f) + EPS) * li1;
                    uint2 o; o.x = pk2(d0 * rs * s4.x * bflo(zw[q].x), d1 * rs * s4.y * bfhi(zw[q].x)); o.y = pk2(d2 * rs * s4.z * bflo(zw[q].y), d3 * rs * s4.w * bfhi(zw[q].y));
                    if (it < lim) *(uint2*)(Y + (size_t)row * DM + 1024 + h * 256 + lane * 4) = o; } } } }
        GSYNC();

}
        RETID();
        if (l < 3) { for (int rep_ = 0; rep_ < (PROBE_DUP == 9 ? 3 : 1); ++rep_) for (int tile = bid; tile < 256; tile += G) ctx_out_tile(Y, WOUT + (size_t)l * 2048 * 2048, l == 0 ? p.in[2] : X + (size_t)TL * DM, rep_ == 0 ? X : AO, mod + 6144 + 4096, tile, L, tid); }
        { const int M2 = TL;
          pg8::Gemm g{Y, WOUT + (size_t)l * 2048 * 2048, M2, DM, DM}; pg8::StaticOrder S; S.init(M2, DM, G, bid);
          pg8::EpiOut E{X, l == 0 ? p.in[0] : X, mod};
          pg8::gemm_phase<pg8::EpiOut, pg8::StaticOrder, true, true>(L, g, S, E); }
        GSYNC();
    }
    RETID();
    { const float* fw = p.in[17];
      for (int row = gw; row < TL; row += ngw) {
          const float4* xr = (const float4*)(X + (size_t)row * DM) + lane; float4 v[8]; float ss = 0.f;
#pragma unroll
          for (int j = 0; j < 8; ++j) { v[j] = xr[64 * j]; ss += v[j].x * v[j].x + v[j].y * v[j].y + v[j].z * v[j].z + v[j].w * v[j].w; }
          const float r = rsqrtf(wave_sum(ss) * (1.f / DM) + EPS);
          float4* op = (float4*)(p.out + (size_t)row * DM) + lane;
#pragma unroll
          for (int j = 0; j < 8; ++j) { const float4 w4 = *(const float4*)(fw + 4 * (lane + 64 * j)); op[64 * j] = make_float4(v[j].x * r * w4.x, v[j].y * r * w4.y, v[j].z * r * w4.z, v[j].w * r * w4.w); } } }
}

extern "C" void kernel_launch(void* const* d_in, const int* in_sizes, int n_in, void* d_out, int out_size, void* d_ws, size_t ws_size, hipStream_t stream) {
    static int grid = 0;
    if (grid == 0) {
        if (n_in != 18 || out_size != TL * DM || ws_size < WS_END) { fprintf(stderr, "kernel_launch: unexpected shapes (n_in %d out %d ws %zu need %zu)\n", n_in, out_size, ws_size, (size_t)WS_END); grid = -1; return; }
        int dev = 0, cus = 0, per_cu = 0;
        (void)hipGetDevice(&dev); (void)hipDeviceGetAttribute(&cus, hipDeviceAttributeMultiprocessorCount, dev);
        if (hipFuncSetAttribute((const void*)mega, hipFuncAttributeMaxDynamicSharedMemorySize, LDS_BYTES) != hipSuccess) { fprintf(stderr, "kernel_launch: hipFuncSetAttribute failed\n"); grid = -1; return; }
        (void)hipOccupancyMaxActiveBlocksPerMultiprocessor(&per_cu, (const void*)mega, 512, LDS_BYTES);
        if (per_cu < 1) per_cu = 1;
        grid = cus * per_cu;
        fprintf(stderr, "kernel_launch: grid %d (cus %d x %d)\n", grid, cus, per_cu);
    }
    if (grid < 0) return;
    if (hipMemsetAsync((char*)d_ws + WS_CTL, 0, (size_t)CTL_WORDS * 4, stream) != hipSuccess) { fprintf(stderr, "kernel_launch: memset failed\n"); return; }
    Params p{};
    for (int i = 0; i < 18; ++i) p.in[i] = (const float*)d_in[i];
    p.out = (float*)d_out; p.ws = (unsigned char*)d_ws;
    void* args[] = {&p};
    hipError_t e = hipLaunchCooperativeKernel((const void*)mega, dim3(grid), dim3(512), args, LDS_BYTES, stream);
    if (e != hipSuccess) fprintf(stderr, "kernel_launch: cooperative launch failed: %s (grid %d)\n", hipGetErrorString(e), grid);
}
```

```cpp
#include <hip/hip_runtime.h>
#include <hip/hip_bf16.h>
#include <hip/hip_cooperative_groups.h>
#include <cstdio>
#include <cstdint>
namespace cg = cooperative_groups;
__device__ __forceinline__ int tidx() { int t = threadIdx.x; asm volatile("" : "+v"(t)); return t; }
#define LAS __attribute__((address_space(3)))
namespace pg8 {
#define PG8_LAS __attribute__((address_space(3)))
typedef unsigned short bf16_t;
typedef short bf16x8 __attribute__((ext_vector_type(8)));
typedef float f32x4 __attribute__((ext_vector_type(4)));
typedef unsigned u32x4 __attribute__((ext_vector_type(4)));
constexpr int BM = 256, BK = 64, HALF = 128, HTB = HALF * BK * 2  , STAGE_BYTES = 8 * HTB, NXCD = 8, WGM = 8;

__host__ __device__ __forceinline__ int lds_byte(int r, int c) { const int st = (r >> 4) * 2 + (c >> 5), rr = r & 15, cc = c & 31, ob = rr * 64 + cc * 2; return st * 1024 + (ob ^ (((ob >> 9) & 1) << 5)); }
__host__ __device__ __forceinline__ void stage_rc(int b, int& R, int& C) { const int st = b / 1024, sb = b % 1024, swz = sb ^ (((sb >> 9) & 1) << 5); R = (st >> 1) * 16 + swz / 64; C = (st & 1) * 32 + (swz % 64) / 2; }
__host__ __device__ __forceinline__ int perm32(int rho) { const int n = rho >> 4, i = rho & 15; return 8 * (i >> 2) + 4 * n + (i & 3); }

struct Unit { int pm, pn; };
struct Gemm { const bf16_t* A; const bf16_t* Bt; int M, N, K; };

struct StaticOrder {
    int nM, nN, nwg, G, c;
    __host__ __device__ void init(int M, int N, int G_, int c_) { nM = M / BM; nN = N / BM; nwg = nM * nN; G = G_; c = c_; }
    __host__ __device__ bool next(int i, Unit& u) const {
        const long L = (long)i * G + c; if (L >= nwg) return false;
        int wgid = (int)L; { const int q = nwg / NXCD, r = nwg % NXCD, xcd = wgid % NXCD, off = wgid / NXCD; wgid = (xcd < r ? xcd * (q + 1) : r * (q + 1) + (xcd - r) * q) + off; }
        const int nig = WGM * nN, gid = wgid / nig, fm = gid * WGM, gsz = (nM - fm) < WGM ? (nM - fm) : WGM;
        u.pm = fm + ((wgid % nig) % gsz); u.pn = (wgid % nig) / gsz; return true;
    }
    __device__ __forceinline__ void a_ready(const Unit&) const {}
    __device__ __forceinline__ void done(const Unit&) const {}
};

__device__ __forceinline__ unsigned cvt_pk_bf16(float lo, float hi) { unsigned r; asm volatile("v_cvt_pk_bf16_f32 %0, %1, %2" : "=v"(r) : "v"(lo), "v"(hi)); return r; }
typedef float f32x2 __attribute__((ext_vector_type(2)));
__device__ __forceinline__ f32x2 gelu_pk(f32x2 v) {
    const f32x2 av = __builtin_elementwise_abs(v), d = av * 0.2316418882f + 1.0f;
    f32x2 t; t.x = __builtin_amdgcn_rcpf(d.x); t.y = __builtin_amdgcn_rcpf(d.y);
    f32x2 q = t * 0.5307027145f + (-0.7265760135f); q = q * t + 0.7107068705f; q = q * t + (-0.142248368f); q = q * t + 0.127414796f; q = q * t;
    const f32x2 s = (v * v) * (-0.72134752044f);
    f32x2 e; e.x = __builtin_amdgcn_exp2f(s.x); e.y = __builtin_amdgcn_exp2f(s.y);
    const f32x2 m = v * (q * e), r = v - m;
    f32x2 o; o.x = v.x < 0.f ? m.x : r.x; o.y = v.y < 0.f ? m.y : r.y; return o;
}

__device__ __forceinline__ float silu1(float x) { return x * __builtin_amdgcn_rcpf(1.f + __expf(-x)); }
struct EpiProj {
    static constexpr bool PERM = true, AFTER_DRAIN = false;
    bf16_t* O;
    __device__ __forceinline__ void operator()(const f32x4 (&acc)[2][2][4][2], const Unit& u, int wr, int wc, int fr, int fq) const {
        const int row0 = u.pm * BM + wr * 64 + fr; const int colt = u.pn * BM; const int col0 = colt + wc * 32 + 8 * fq;
        const int seg = colt >> 9;
        int mode = (int)((0x2200333320002211ULL >> (4 * seg)) & 15ULL);
        if (mode == 3 && u.pm >= 32) mode = 0;
        float ir[4] = {0.f, 0.f, 0.f, 0.f};
        if (mode == 3) { const int i0 = (wc & 1) * 16 + 4 * fq;
#pragma unroll
            for (int p = 0; p < 4; ++p) ir[p] = __builtin_amdgcn_exp2f(-(float)(i0 + p) * 0.41524101186092f) * 0.15915494309189535f; }
        const bool colaxis = (wc >> 1) != 0;
#pragma unroll
        for (int ai = 0; ai < 2; ++ai)
#pragma unroll
            for (int m = 0; m < 4; ++m) { const int row = row0 + ai * HALF + m * 16; bf16_t* rowp = O + (size_t)row * 8256 + col0;
                const float pos = (float)(colaxis ? (row & 63) : (row >> 6));
#pragma unroll
                for (int bj = 0; bj < 2; ++bj) { f32x4 v0 = acc[ai][bj][m][0], v1 = acc[ai][bj][m][1];
                    if (mode == 1) { f32x2 a = gelu_pk((f32x2){v0[0], v0[1]}), b = gelu_pk((f32x2){v0[2], v0[3]}), c = gelu_pk((f32x2){v1[0], v1[1]}), d = gelu_pk((f32x2){v1[2], v1[3]});
                        v0 = (f32x4){a.x, a.y, b.x, b.y}; v1 = (f32x4){c.x, c.y, d.x, d.y}; }
                    else if (mode == 2) {
#pragma unroll
                        for (int j = 0; j < 4; ++j) { v0[j] = silu1(v0[j]); v1[j] = silu1(v1[j]); } }
                    else if (mode == 3) {
                        float c0 = __builtin_amdgcn_cosf(pos * ir[0]), s0 = __builtin_amdgcn_sinf(pos * ir[0]);
                        float c1 = __builtin_amdgcn_cosf(pos * ir[1]), s1 = __builtin_amdgcn_sinf(pos * ir[1]);
                        float c2 = __builtin_amdgcn_cosf(pos * ir[2]), s2 = __builtin_amdgcn_sinf(pos * ir[2]);
                        float c3 = __builtin_amdgcn_cosf(pos * ir[3]), s3 = __builtin_amdgcn_sinf(pos * ir[3]);
                        f32x4 w0, w1;
                        w0[0] = v0[0] * c0 - v0[1] * s0; w0[1] = v0[1] * c0 + v0[0] * s0;
                        w0[2] = v0[2] * c1 - v0[3] * s1; w0[3] = v0[3] * c1 + v0[2] * s1;
                        w1[0] = v1[0] * c2 - v1[1] * s2; w1[1] = v1[1] * c2 + v1[0] * s2;
                        w1[2] = v1[2] * c3 - v1[3] * s3; w1[3] = v1[3] * c3 + v1[2] * s3;
                        v0 = w0; v1 = w1; }
                    u32x4 w; w.x = cvt_pk_bf16(v0[0], v0[1]); w.y = cvt_pk_bf16(v0[2], v0[3]); w.z = cvt_pk_bf16(v1[0], v1[1]); w.w = cvt_pk_bf16(v1[2], v1[3]);
                    *(u32x4*)(rowp + bj * HALF) = w; } }
    }
};
struct EpiOut {
    static constexpr bool PERM = false, AFTER_DRAIN = false;
    float* X; const float* Xin; const float* mod;
    __device__ __forceinline__ void operator()(const f32x4 (&acc)[2][2][4][2], const Unit& u, int wr, int wc, int fr, int fq) const {
        const int row0 = u.pm * BM + wr * 64 + fr, col0 = u.pn * BM + wc * 32 + 4 * fq;
        const float* g = mod + (u.pm >= 32 ? 6144 : 0) + 4096;
        f32x4 gv[2][2];
#pragma unroll
        for (int bj = 0; bj < 2; ++bj)
#pragma unroll
            for (int n = 0; n < 2; ++n) gv[bj][n] = *(const f32x4*)(g + col0 + bj * HALF + n * 16);
#pragma unroll
        for (int ai = 0; ai < 2; ++ai) { f32x4 xin[4][2][2];
#pragma unroll
            for (int m = 0; m < 4; ++m) { const float* rowi = Xin + (size_t)(row0 + ai * HALF + m * 16) * 2048 + col0;
#pragma unroll
                for (int bj = 0; bj < 2; ++bj)
#pragma unroll
                    for (int n = 0; n < 2; ++n) xin[m][bj][n] = *(const f32x4*)(rowi + bj * HALF + n * 16); }
            asm volatile("" ::: "memory");
#pragma unroll
            for (int m = 0; m < 4; ++m) { float* rowp = X + (size_t)(row0 + ai * HALF + m * 16) * 2048 + col0;
#pragma unroll
                for (int bj = 0; bj < 2; ++bj)
#pragma unroll
                    for (int n = 0; n < 2; ++n) *(f32x4*)(rowp + bj * HALF + n * 16) = xin[m][bj][n] + gv[bj][n] * acc[ai][bj][m][n]; }
            asm volatile("" ::: "memory"); }
    }
};
struct MainOrder : StaticOrder {
    __device__ bool next(int i, Unit& u) const {
        if (!StaticOrder::next(i, u)) return false;
        if (u.pn >= 28 && u.pm >= 29) { const int j = (31 - u.pm) * 4 + (u.pn - 28); u.pm = 32; u.pn = (j < 6) ? j : 8 + (j - 6); }
        return true;
    }
};
struct TailOrder {
    int t;
    __device__ bool next(int i, Unit& u) const {
        if (i != 0 || t >= 32) return false;
        if (t < 2) { u.pm = 32; u.pn = 6 + t; } else if (t < 20) { u.pm = 32; u.pn = 14 + (t - 2); } else { const int j = t - 20; u.pm = 31 - (j >> 2); u.pn = 28 + (j & 3); }
        return true;
    }
    __device__ __forceinline__ void a_ready(const Unit&) const {}
    __device__ __forceinline__ void done(const Unit&) const {}
};
struct PanelOrder {
    int pm, pn;
    __device__ bool next(int i, Unit& u) const { if (i != 0) return false; u.pm = pm; u.pn = pn; return true; }
    __device__ __forceinline__ void a_ready(const Unit&) const {}
    __device__ __forceinline__ void done(const Unit&) const {}
};
template <class Epi, class Sched, bool ALIGN_EPI = false, bool SP2 = false>
__device__ __forceinline__ void gemm_phase(PG8_LAS unsigned char* lds, const Gemm g, const Sched& S, const Epi& E) {
    const int tid = tidx(), wid = __builtin_amdgcn_readfirstlane(tid >> 6), lane = tid & 63, wr = wid >> 2, wc = wid & 3, fr = lane & 15, fq = lane >> 4;
    const int K = g.K, nt = K / BK;
    unsigned voffA[2], voffB[2];
#pragma unroll
    for (int i = 0; i < 2; ++i) { int R, C; stage_rc(tid * 16 + i * 8192, R, C); const int Rb = Epi::PERM ? ((R & ~31) + perm32(R & 31)) : R;
        voffA[i] = (unsigned)(R * K + C) * 2u; voffB[i] = (unsigned)(Rb * K + C) * 2u; }
    const size_t kstep = (size_t)(BK * 2);
    const size_t hstep = (size_t)HALF * K * 2;
    const size_t tstep = 2 * hstep;
    const unsigned ldsw = (unsigned)wid * 1024u;
    const int aoff = lds_byte(wr * 64 + fr, fq * 8), boff = lds_byte(wc * 32 + fr, fq * 8);
#define PG8_SA(b, h) (((b) * 2 + (h)) * HTB)
#define PG8_SB(b, h) ((4 + (b) * 2 + (h)) * HTB)
#define PG8_STAGE(bufoff, gbase, voff) do { _Pragma("unroll") for (int _i = 0; _i < 2; ++_i) \
        __builtin_amdgcn_global_load_lds((const unsigned*)((const char*)(gbase) + (voff)[_i]), (PG8_LAS unsigned*)(lds + (bufoff) + ldsw + _i * 8192), 16, 0, 0); } while (0)
#define PG8_LDA(dst, b, h) do { _Pragma("unroll") for (int m = 0; m < 4; ++m) _Pragma("unroll") for (int k = 0; k < 2; ++k) dst[m][k] = *(const PG8_LAS bf16x8*)(lds + PG8_SA(b, h) + aoff + m * 2048 + k * 1024); } while (0)
#define PG8_LDB(dst, b, h) do { _Pragma("unroll") for (int n = 0; n < 2; ++n) _Pragma("unroll") for (int k = 0; k < 2; ++k) dst[n][k] = *(const PG8_LAS bf16x8*)(lds + PG8_SB(b, h) + boff + n * 2048 + k * 1024); } while (0)
#define PG8_MMA(ai, bj, At, Bt) do { __builtin_amdgcn_s_setprio(1); _Pragma("unroll") for (int m = 0; m < 4; ++m) _Pragma("unroll") for (int n = 0; n < 2; ++n) _Pragma("unroll") for (int k = 0; k < 2; ++k) \
        acc[ai][bj][m][n] = __builtin_amdgcn_mfma_f32_16x16x32_bf16(Bt[n][k], At[m][k], acc[ai][bj][m][n], 0, 0, 0); __builtin_amdgcn_s_setprio(0); } while (0)
#define PG8_WAIT_V(n) asm volatile("s_waitcnt vmcnt(" #n ")" ::: "memory")
#define PG8_WAIT_L(n) asm volatile("s_waitcnt lgkmcnt(" #n ")" ::: "memory")
#define PG8_BAR __builtin_amdgcn_s_barrier()
#define PG8_SCHED __builtin_amdgcn_sched_barrier(0)
    Unit cur, nxt; int ui = 0;
    if (!S.next(0, cur)) return;
    f32x4 acc[2][2][4][2];
#pragma unroll
    for (int a = 0; a < 2; ++a)
#pragma unroll
        for (int b = 0; b < 2; ++b)
#pragma unroll
            for (int m = 0; m < 4; ++m)
#pragma unroll
                for (int n = 0; n < 2; ++n) acc[a][b][m][n] = (f32x4){0.f, 0.f, 0.f, 0.f};
    bf16x8 At[4][2], B0[2][2], B1[2][2];
    const char* cA = (const char*)g.A + (size_t)cur.pm * tstep; const char* cB = (const char*)g.Bt + (size_t)cur.pn * tstep;
    S.a_ready(cur);
    if constexpr (SP2) {
        PG8_STAGE(PG8_SB(0, 0), cB, voffB); PG8_STAGE(PG8_SB(0, 1), cB + hstep, voffB); PG8_STAGE(PG8_SA(0, 0), cA, voffA); PG8_STAGE(PG8_SA(0, 1), cA + hstep, voffA);
        if (wr == 1) PG8_BAR;
        PG8_WAIT_V(2); PG8_BAR;
        PG8_STAGE(PG8_SB(1, 0), cB + kstep, voffB); PG8_STAGE(PG8_SA(1, 0), cA + kstep, voffA); PG8_STAGE(PG8_SB(1, 1), cB + hstep + kstep, voffB);
        PG8_WAIT_V(6); PG8_BAR;
    } else {
        PG8_STAGE(PG8_SB(0, 0), cB, voffB); PG8_STAGE(PG8_SA(0, 0), cA, voffA); PG8_STAGE(PG8_SB(0, 1), cB + hstep, voffB); PG8_STAGE(PG8_SA(0, 1), cA + hstep, voffA);
        if (wr == 1) PG8_BAR;
        PG8_WAIT_V(4); PG8_BAR;
        PG8_STAGE(PG8_SB(1, 0), cB + kstep, voffB); PG8_STAGE(PG8_SA(1, 0), cA + kstep, voffA); PG8_STAGE(PG8_SB(1, 1), cB + hstep + kstep, voffB);
        PG8_WAIT_V(6); PG8_BAR;
    }
    for (;;) {
        const bool has_next = S.next(ui + 1, nxt);
        const char* nA = has_next ? (const char*)g.A + (size_t)nxt.pm * tstep : cA; const char* nB = has_next ? (const char*)g.Bt + (size_t)nxt.pn * tstep : cB;
        for (int t = 0; t < nt; t += 2) {
            const bool last = (t == nt - 2);
            const char* a1 = cA + (size_t)(t + 1) * kstep;
            const char* a2 = last ? nA : cA + (size_t)(t + 2) * kstep; const char* b2 = last ? nB : cB + (size_t)(t + 2) * kstep;
            const char* a3 = a2 + kstep; const char* b3 = b2 + kstep;
            if (last && has_next) S.a_ready(nxt);
            if constexpr (SP2) {
            PG8_LDB(B0, 0, 0); PG8_LDB(B1, 0, 1); PG8_SCHED; PG8_LDA(At, 0, 0); PG8_STAGE(PG8_SA(1, 1), a1 + hstep, voffA);
            PG8_WAIT_V(8); PG8_WAIT_L(0); PG8_BAR; PG8_MMA(0, 0, At, B0); PG8_MMA(0, 1, At, B1); PG8_BAR; PG8_SCHED;
            PG8_LDA(At, 0, 1); PG8_STAGE(PG8_SB(0, 0), b2, voffB); PG8_STAGE(PG8_SB(0, 1), b2 + hstep, voffB); PG8_STAGE(PG8_SA(0, 0), a2, voffA);
            PG8_WAIT_V(8); PG8_WAIT_L(0); PG8_BAR; PG8_MMA(1, 0, At, B0); PG8_MMA(1, 1, At, B1); PG8_BAR; PG8_SCHED;
            PG8_LDB(B0, 1, 0); PG8_LDB(B1, 1, 1); PG8_SCHED; PG8_LDA(At, 1, 0); PG8_STAGE(PG8_SA(0, 1), a2 + hstep, voffA);
            PG8_WAIT_V(8); PG8_WAIT_L(0); PG8_BAR; PG8_MMA(0, 0, At, B0); PG8_MMA(0, 1, At, B1); PG8_BAR; PG8_SCHED;
            PG8_LDA(At, 1, 1); PG8_STAGE(PG8_SB(1, 0), b3, voffB); PG8_STAGE(PG8_SB(1, 1), b3 + hstep, voffB); PG8_STAGE(PG8_SA(1, 0), a3, voffA);
            PG8_WAIT_V(8); PG8_WAIT_L(0); PG8_BAR; PG8_MMA(1, 0, At, B0); PG8_MMA(1, 1, At, B1); PG8_BAR; PG8_SCHED;
            } else {
            PG8_LDB(B0, 0, 0); PG8_SCHED; PG8_LDA(At, 0, 0); PG8_STAGE(PG8_SA(1, 1), a1 + hstep, voffA);
            PG8_WAIT_L(8); PG8_BAR; PG8_WAIT_L(0); PG8_MMA(0, 0, At, B0); PG8_BAR; PG8_SCHED;
            PG8_LDB(B1, 0, 1); PG8_STAGE(PG8_SB(0, 0), b2, voffB);
            PG8_BAR; PG8_WAIT_L(0); PG8_MMA(0, 1, At, B1); PG8_BAR;
            PG8_LDA(At, 0, 1); PG8_STAGE(PG8_SA(0, 0), a2, voffA);
            PG8_BAR; PG8_WAIT_L(0); PG8_MMA(1, 0, At, B0); PG8_BAR; PG8_SCHED;
            PG8_STAGE(PG8_SB(0, 1), b2 + hstep, voffB);
            PG8_WAIT_V(6); PG8_BAR; PG8_MMA(1, 1, At, B1); PG8_BAR;
            PG8_LDB(B0, 1, 0); PG8_SCHED; PG8_LDA(At, 1, 0); PG8_STAGE(PG8_SA(0, 1), a2 + hstep, voffA);
            PG8_WAIT_L(8); PG8_BAR; PG8_WAIT_L(0); PG8_MMA(0, 0, At, B0); PG8_BAR; PG8_SCHED;
            PG8_LDB(B1, 1, 1); PG8_STAGE(PG8_SB(1, 0), b3, voffB);
            PG8_BAR; PG8_WAIT_L(0); PG8_MMA(0, 1, At, B1); PG8_BAR;
            PG8_LDA(At, 1, 1); PG8_STAGE(PG8_SA(1, 0), a3, voffA);
            PG8_BAR; PG8_WAIT_L(0); PG8_MMA(1, 0, At, B0); PG8_BAR; PG8_SCHED;
            PG8_STAGE(PG8_SB(1, 1), b3 + hstep, voffB);
            PG8_WAIT_V(6); PG8_BAR; PG8_MMA(1, 1, At, B1); PG8_BAR;
            }
        }
        if constexpr (ALIGN_EPI) { if (wr == 0) PG8_BAR; }
        if constexpr (!Epi::AFTER_DRAIN) { E(acc, cur, wr, wc, fr, fq); S.done(cur); }
        if (!has_next) break;
#pragma unroll
        for (int a = 0; a < 2; ++a)
#pragma unroll
            for (int b = 0; b < 2; ++b)
#pragma unroll
                for (int m = 0; m < 4; ++m)
#pragma unroll
                    for (int n = 0; n < 2; ++n) acc[a][b][m][n] = (f32x4){0.f, 0.f, 0.f, 0.f};
        cur = nxt; cA = nA; cB = nB; ++ui;
        if constexpr (ALIGN_EPI) { if (wr == 1) PG8_BAR; }
    }
    PG8_WAIT_V(0);
    if constexpr (!ALIGN_EPI) { if (wr == 0) PG8_BAR; }
    PG8_BAR;
    if constexpr (Epi::AFTER_DRAIN) { E.fused(acc, cur, wr, wc, fr, fq, lds, wid, lane); S.done(cur); }
#undef PG8_SA
#undef PG8_SB
#undef PG8_STAGE
#undef PG8_LDA
#undef PG8_LDB
#undef PG8_MMA
#undef PG8_WAIT_V
#undef PG8_WAIT_L
#undef PG8_BAR
#undef PG8_SCHED
}
}
namespace att {
using bf16 = __hip_bfloat16;
constexpr int   D = 128, NW = 8, QBLK = 32, KVBLK = 64;
constexpr float SCALE = 0.088388347648318440f;
constexpr float THR = 8.f;
constexpr int SDEPTH = 2;
constexpr int LDQ = 8256, LDK = 8256, LDO = 2048;
constexpr size_t SHM_V = KVBLK * D * 2, SHM_K = KVBLK * D * 2, SHM_ATTN = 2 * SHM_V + 2 * SHM_K + NW * 64 * 4;
using bf16x8 = __attribute__((ext_vector_type(8))) short;
using s16x4  = __attribute__((ext_vector_type(4))) short;
using f32x16 = __attribute__((ext_vector_type(16))) float;
using f32x8  = __attribute__((ext_vector_type(8))) float;
using u32x4  = __attribute__((ext_vector_type(4))) unsigned;
#define KSWZ(row, colB) ((row) * 256 + ((colB) ^ (((row) & 7) << 4)))
#define SBAR() __builtin_amdgcn_sched_barrier(0)
__device__ __forceinline__ int crow(int r, int hi) { return (r & 3) + 8 * (r >> 2) + 4 * hi; }
__device__ __forceinline__ unsigned cvtpk(float lo, float hi) {
  unsigned r; asm volatile("v_cvt_pk_bf16_f32 %0, %1, %2" : "=v"(r) : "v"(lo), "v"(hi)); return r;
}
template <typename TIn> struct Stage;
template <> struct Stage<bf16>  { using T = bf16x8;
  __device__ static __forceinline__ T ld8(const bf16* p) { return *reinterpret_cast<const bf16x8*>(p); }
  __device__ static __forceinline__ bf16x8 tobf(T x) { return x; } };
template <> struct Stage<float> { using T = f32x8;
  __device__ static __forceinline__ T ld8(const float* p) { return *reinterpret_cast<const f32x8*>(p); }
  __device__ static __forceinline__ bf16x8 tobf(T x) {
    u32x4 w = {cvtpk(x[0], x[1]), cvtpk(x[2], x[3]), cvtpk(x[4], x[5]), cvtpk(x[6], x[7])}; return *reinterpret_cast<bf16x8*>(&w); } };

__device__ __forceinline__ void partialSM(f32x16& p0, f32x16& p1, float& m_reg, float& mn, float& alpha) {
  constexpr float C = SCALE * 1.4426950408889634f;
  float pmax = p0[0]; for (int r = 1; r < 16; ++r) pmax = fmaxf(pmax, p0[r]); for (int r = 0; r < 16; ++r) pmax = fmaxf(pmax, p1[r]);
  { auto rr = __builtin_amdgcn_permlane32_swap(__float_as_uint(pmax), __float_as_uint(pmax), false, false);
    pmax = fmaxf(__uint_as_float(rr[0]), __uint_as_float(rr[1])); }
  if (__builtin_expect(__all(pmax - m_reg <= THR / SCALE), 1)) { mn = m_reg; alpha = 1.f; }
  else { mn = fmaxf(m_reg, pmax); alpha = __builtin_amdgcn_exp2f((m_reg - mn) * C); m_reg = mn; }
  float mnC = -mn * C;
  for (int r = 0; r < 16; ++r) p0[r] = fmaf(p0[r], C, mnC); for (int r = 0; r < 16; ++r) p1[r] = fmaf(p1[r], C, mnC);
  for (int r = 0; r < 16; ++r) p0[r] = __builtin_amdgcn_exp2f(p0[r]);
}
__device__ __forceinline__ void finishSM(f32x16& p0, f32x16& p1, float alpha, float& l_reg, bf16x8& pa0, bf16x8& pa1, bf16x8& pa2, bf16x8& pa3) {
  for (int r = 0; r < 16; ++r) p1[r] = __builtin_amdgcn_exp2f(p1[r]);
  float ps = 0; for (int r = 0; r < 16; ++r) ps += p0[r]; for (int r = 0; r < 16; ++r) ps += p1[r];
  { auto rr = __builtin_amdgcn_permlane32_swap(__float_as_uint(ps), __float_as_uint(ps), false, false);
    ps = __uint_as_float(rr[0]) + __uint_as_float(rr[1]); }
  l_reg = l_reg * alpha + ps;
#define PK4(P, BASE, OUT) do { unsigned a0 = cvtpk(P[BASE + 0], P[BASE + 1]), a1 = cvtpk(P[BASE + 2], P[BASE + 3]);   \
    unsigned b0 = cvtpk(P[BASE + 4], P[BASE + 5]), b1 = cvtpk(P[BASE + 6], P[BASE + 7]);                              \
    auto r0 = __builtin_amdgcn_permlane32_swap(a0, b0, false, false); auto r1 = __builtin_amdgcn_permlane32_swap(a1, b1, false, false); \
    u32x4 w = {r0[0], r1[0], r0[1], r1[1]}; OUT = *reinterpret_cast<bf16x8*>(&w); } while (0)
  PK4(p0, 0, pa0); PK4(p0, 8, pa1); PK4(p1, 0, pa2); PK4(p1, 8, pa3);
#undef PK4
}
__device__ __forceinline__ void qkt(f32x16& p0, f32x16& p1, const bf16* Ks, const bf16x8* qr, int r32, int hi) {
  p0 = f32x16{}; p1 = f32x16{};
  for (int d0 = 0; d0 < 8; ++d0) { int cb = (d0 * 16 + hi * 8) * 2;
    bf16x8 b0 = *reinterpret_cast<const bf16x8*>((const char*)Ks + KSWZ(r32, cb));
    bf16x8 b1 = *reinterpret_cast<const bf16x8*>((const char*)Ks + KSWZ(32 + r32, cb));
    p0 = __builtin_amdgcn_mfma_f32_32x32x16_bf16(b0, qr[d0], p0, 0, 0, 0);
    p1 = __builtin_amdgcn_mfma_f32_32x32x16_bf16(b1, qr[d0], p1, 0, 0, 0); }
}
__device__ __forceinline__ int v_st(int k, int c) { const int kk = (k & ~0xC) | ((k & 4) << 1) | ((k & 8) >> 1); return ((kk >> 3) * 4 + (c >> 5)) * 512 + ((kk & 7) * 32 + (c & 31)) * 2; }
__device__ __forceinline__ int v_rd_base(int lane) { return ((lane & 3) << 3) | (((lane >> 2) & 3) << 6) | (((lane >> 4) & 1) << 5) | (((lane >> 5) & 1) << 8); }
constexpr int v_rd_off(int d0, int ks, int half) { return d0 * 512 + ks * 4096 + half * 2048; }
template <int OFF> __device__ __forceinline__ s16x4 tr_read(int vb) {
  s16x4 r; asm volatile("ds_read_b64_tr_b16 %0, %1 offset:%2" : "=&v"(r) : "v"(vb), "i"(OFF) : "memory"); return r;
}
template <int D0> __device__ __forceinline__ void pv_one(f32x16& od, int vb, bf16x8 pa0, bf16x8 pa1, bf16x8 pa2, bf16x8 pa3) {
  const s16x4 l0 = tr_read<v_rd_off(D0, 0, 0)>(vb), h0 = tr_read<v_rd_off(D0, 0, 1)>(vb), l1 = tr_read<v_rd_off(D0, 1, 0)>(vb), h1 = tr_read<v_rd_off(D0, 1, 1)>(vb);
  const s16x4 l2 = tr_read<v_rd_off(D0, 2, 0)>(vb), h2 = tr_read<v_rd_off(D0, 2, 1)>(vb), l3 = tr_read<v_rd_off(D0, 3, 0)>(vb), h3 = tr_read<v_rd_off(D0, 3, 1)>(vb);
  asm volatile("s_waitcnt lgkmcnt(0)" ::: "memory"); SBAR();
#define PK(L, H) (bf16x8){L[0], L[1], L[2], L[3], H[0], H[1], H[2], H[3]}
  od = __builtin_amdgcn_mfma_f32_32x32x16_bf16(pa0, PK(l0, h0), od, 0, 0, 0);
  od = __builtin_amdgcn_mfma_f32_32x32x16_bf16(pa1, PK(l1, h1), od, 0, 0, 0);
  od = __builtin_amdgcn_mfma_f32_32x32x16_bf16(pa2, PK(l2, h2), od, 0, 0, 0);
  od = __builtin_amdgcn_mfma_f32_32x32x16_bf16(pa3, PK(l3, h3), od, 0, 0, 0);
#undef PK
}
__device__ __forceinline__ void pv_d0(f32x16* o, int vb, bf16x8 pa0, bf16x8 pa1, bf16x8 pa2, bf16x8 pa3) {
  pv_one<0>(o[0], vb, pa0, pa1, pa2, pa3); pv_one<1>(o[1], vb, pa0, pa1, pa2, pa3); pv_one<2>(o[2], vb, pa0, pa1, pa2, pa3); pv_one<3>(o[3], vb, pa0, pa1, pa2, pa3);
}

template <typename TQ>
__device__ __forceinline__ void attn_dense_body(const TQ* __restrict__ Qb, const bf16* __restrict__ Kh, const bf16* __restrict__ Vh,
                                                float* __restrict__ Ob, int seq, char* lds) {
  using St = Stage<bf16>; using SQ = Stage<TQ>;
  const int tid = tidx(), wid = tid >> 6, lane = tid & 63, r32 = lane & 31, hi = lane >> 5;
  bf16* V_lds = (bf16*)lds; bf16* K_lds = (bf16*)(lds + 2 * SHM_V);
  float* ws = (float*)(lds + 2 * SHM_V + 2 * SHM_K) + wid * 64; float* li_l = ws; float* al_l = ws + 32;
  float m_reg = -1e30f, l_reg = 0; f32x16 o[4] = {}; bf16x8 qr[8];
  const TQ* Qw = Qb + (long)(wid * QBLK + r32) * LDQ + hi * 8;
#pragma unroll
  for (int d0 = 0; d0 < 8; ++d0) qr[d0] = SQ::tobf(SQ::ld8(Qw + d0 * 16));
  const int sr = tid >> 4, sc = (tid & 15) * 8, vst0 = v_st(sr, sc), vst1 = v_st(32 + sr, sc);
  const int vb0 = (int)(uintptr_t)V_lds + v_rd_base(lane);
  struct { typename St::T vs0, vs1, ks0, ks1; } sr_[SDEPTH];
#define SLOAD(i, k0) do { sr_[i].vs0 = St::ld8(&Vh[(long)((k0) + sr) * LDK + sc]); sr_[i].vs1 = St::ld8(&Vh[(long)((k0) + 32 + sr) * LDK + sc]); \
    sr_[i].ks0 = St::ld8(&Kh[(long)((k0) + sr) * LDK + sc]); sr_[i].ks1 = St::ld8(&Kh[(long)((k0) + 32 + sr) * LDK + sc]); } while (0)
#define SWRITE(b, i) do { *(bf16x8*)((char*)V_lds + (b) * SHM_V + vst0) = St::tobf(sr_[i].vs0);          \
    *(bf16x8*)((char*)V_lds + (b) * SHM_V + vst1) = St::tobf(sr_[i].vs1); int kc = sc * 2;               \
    *(bf16x8*)((char*)K_lds + (b) * SHM_K + KSWZ(sr, kc)) = St::tobf(sr_[i].ks0);                       \
    *(bf16x8*)((char*)K_lds + (b) * SHM_K + KSWZ(32 + sr, kc)) = St::tobf(sr_[i].ks1); } while (0)
#define SWAIT() do { if constexpr (SDEPTH == 2) asm volatile("s_waitcnt vmcnt(4)" ::: "memory"); else asm volatile("s_waitcnt vmcnt(0)" ::: "memory"); } while (0)
#define RESC(a) do { if (__any((a) < 1.f)) { if (hi == 0) al_l[r32] = (a); asm volatile("s_waitcnt lgkmcnt(0)" ::: "memory"); \
    for (int d = 0; d < 4; ++d) for (int r = 0; r < 16; ++r) o[d][r] *= al_l[crow(r, hi)]; } } while (0)
  f32x16 pA0, pA1, pB0, pB1; float mnA, mnB, alA, alB; bf16x8 pa0, pa1, pa2, pa3; const int NT = seq / KVBLK;
  constexpr int SE = 0, SO = SDEPTH - 1;
  SLOAD(SE, 0); asm volatile("s_waitcnt vmcnt(0)" ::: "memory"); SWRITE(0, SE); __syncthreads();
  qkt(pA0, pA1, K_lds, qr, r32, hi); partialSM(pA0, pA1, m_reg, mnA, alA);
  SLOAD(SO, KVBLK); if constexpr (SDEPTH == 2) { if (2 < NT) SLOAD(SE, 2 * KVBLK); }
  SWAIT(); SWRITE(1, SO); __syncthreads();
  for (int j = 1; j + 1 < NT; j += 2) {
    SBAR(); qkt(pB0, pB1, (bf16*)((char*)K_lds + SHM_K), qr, r32, hi);
    finishSM(pA0, pA1, alA, l_reg, pa0, pa1, pa2, pa3); SBAR();
    SLOAD(SO, (j + SDEPTH) * KVBLK); SBAR();
    pv_d0(o, vb0, pa0, pa1, pa2, pa3); partialSM(pB0, pB1, m_reg, mnB, alB);
    __syncthreads(); SWAIT(); SWRITE(0, SE);
    RESC(alB); __syncthreads();
    SBAR(); qkt(pA0, pA1, K_lds, qr, r32, hi);
    finishSM(pB0, pB1, alB, l_reg, pa0, pa1, pa2, pa3); SBAR();
    if (SDEPTH == 1 || j + 3 < NT) SLOAD(SE, (j + 1 + SDEPTH) * KVBLK); SBAR();
    pv_d0(o, vb0 + (int)SHM_V, pa0, pa1, pa2, pa3); partialSM(pA0, pA1, m_reg, mnA, alA);
    __syncthreads(); SWAIT(); SWRITE(1, SO);
    RESC(alA); __syncthreads();
  }
  SBAR(); qkt(pB0, pB1, (bf16*)((char*)K_lds + SHM_K), qr, r32, hi);
  finishSM(pA0, pA1, alA, l_reg, pa0, pa1, pa2, pa3); SBAR();
  pv_d0(o, vb0, pa0, pa1, pa2, pa3); partialSM(pB0, pB1, m_reg, mnB, alB);
  __syncthreads(); RESC(alB);
  finishSM(pB0, pB1, alB, l_reg, pa0, pa1, pa2, pa3); SBAR();
  pv_d0(o, vb0 + (int)SHM_V, pa0, pa1, pa2, pa3);
  if (hi == 0) li_l[r32] = l_reg; asm volatile("s_waitcnt lgkmcnt(0)" ::: "memory");
  float rli[16];
#pragma unroll
  for (int r = 0; r < 16; ++r) rli[r] = __builtin_amdgcn_rcpf(li_l[crow(r, hi)]);
  float* Ow = Ob + (long)(wid * QBLK) * LDO;
#pragma unroll
  for (int r = 0; r < 16; ++r) { int orow = crow(r, hi);
    for (int d0 = 0; d0 < 4; ++d0) Ow[(long)orow * LDO + d0 * 32 + r32] = o[d0][r] * rli[r]; }
#undef SLOAD
#undef SWRITE
#undef SWAIT
#undef RESC
}
struct PvT { s16x4 t[16]; };
template <int DA, int DB> __device__ __forceinline__ void pv2_issue(PvT& T, int vb) {
  T.t[0] = tr_read<v_rd_off(DA, 0, 0)>(vb); T.t[1] = tr_read<v_rd_off(DA, 0, 1)>(vb); T.t[2] = tr_read<v_rd_off(DA, 1, 0)>(vb); T.t[3] = tr_read<v_rd_off(DA, 1, 1)>(vb);
  T.t[4] = tr_read<v_rd_off(DA, 2, 0)>(vb); T.t[5] = tr_read<v_rd_off(DA, 2, 1)>(vb); T.t[6] = tr_read<v_rd_off(DA, 3, 0)>(vb); T.t[7] = tr_read<v_rd_off(DA, 3, 1)>(vb);
  T.t[8] = tr_read<v_rd_off(DB, 0, 0)>(vb); T.t[9] = tr_read<v_rd_off(DB, 0, 1)>(vb); T.t[10] = tr_read<v_rd_off(DB, 1, 0)>(vb); T.t[11] = tr_read<v_rd_off(DB, 1, 1)>(vb);
  T.t[12] = tr_read<v_rd_off(DB, 2, 0)>(vb); T.t[13] = tr_read<v_rd_off(DB, 2, 1)>(vb); T.t[14] = tr_read<v_rd_off(DB, 3, 0)>(vb); T.t[15] = tr_read<v_rd_off(DB, 3, 1)>(vb);
}
__device__ __forceinline__ void pv2_mma(f32x16& oa, f32x16& ob, const PvT& T, bf16x8 pa0, bf16x8 pa1, bf16x8 pa2, bf16x8 pa3) {
  asm volatile("s_waitcnt lgkmcnt(0)" ::: "memory"); SBAR();
#define PK(L, H) (bf16x8){L[0], L[1], L[2], L[3], H[0], H[1], H[2], H[3]}
  oa = __builtin_amdgcn_mfma_f32_32x32x16_bf16(pa0, PK(T.t[0], T.t[1]), oa, 0, 0, 0);
  ob = __builtin_amdgcn_mfma_f32_32x32x16_bf16(pa0, PK(T.t[8], T.t[9]), ob, 0, 0, 0);
  oa = __builtin_amdgcn_mfma_f32_32x32x16_bf16(pa1, PK(T.t[2], T.t[3]), oa, 0, 0, 0);
  ob = __builtin_amdgcn_mfma_f32_32x32x16_bf16(pa1, PK(T.t[10], T.t[11]), ob, 0, 0, 0);
  oa = __builtin_amdgcn_mfma_f32_32x32x16_bf16(pa2, PK(T.t[4], T.t[5]), oa, 0, 0, 0);
  ob = __builtin_amdgcn_mfma_f32_32x32x16_bf16(pa2, PK(T.t[12], T.t[13]), ob, 0, 0, 0);
  oa = __builtin_amdgcn_mfma_f32_32x32x16_bf16(pa3, PK(T.t[6], T.t[7]), oa, 0, 0, 0);
  ob = __builtin_amdgcn_mfma_f32_32x32x16_bf16(pa3, PK(T.t[14], T.t[15]), ob, 0, 0, 0);
#undef PK
}
__device__ __forceinline__ void attn_dv256_body(const bf16* __restrict__ Qb, const bf16* __restrict__ Kh, const bf16* __restrict__ Vh,
                                                float* __restrict__ Ob, int seq, float kmax, char* lds) {
  using St = Stage<bf16>;
  const int tid = tidx(), wid = tid >> 6, lane = tid & 63, r32 = lane & 31, hi = lane >> 5;
  const int rg = wid & 3, kh = wid >> 2;
  char* V_lds = lds; char* K_lds = lds + 65536; char* XCH = lds + 98304; float* LI = (float*)(lds + 131072);
  f32x16 o[4] = {}; bf16x8 qr[8];
  const bf16* Qw = Qb + (long)(rg * 32 + r32) * LDQ + hi * 8;
#pragma unroll
  for (int d0 = 0; d0 < 8; ++d0) qr[d0] = St::ld8(Qw + d0 * 16);
  float qq = 0.f;
#pragma unroll
  for (int d0 = 0; d0 < 8; ++d0)
#pragma unroll
    for (int e = 0; e < 8; ++e) { const float v = __uint_as_float(((unsigned)(unsigned short)qr[d0][e]) << 16); qq += v * v; }
  qq += __shfl_xor(qq, 32);
  constexpr float C = SCALE * 1.4426950408889634f;
  const float mC = -sqrtf(qq) * kmax * C * 1.002f;
  float l_reg = 0.f;
  const int sr = tid >> 4, sc = (tid & 15) * 8, vst0 = v_st(sr, sc), vst1 = v_st(32 + sr, sc);
  const int vb0 = (int)(uintptr_t)V_lds + kh * 16384 + v_rd_base(lane);
  bf16x8 kr0, kr1, vr0, vr1, vr2, vr3;
#define KLOAD(k0) do { kr0 = St::ld8(&Kh[(long)((k0) + sr) * LDK + sc]); kr1 = St::ld8(&Kh[(long)((k0) + 32 + sr) * LDK + sc]); } while (0)
#define VLOAD(k0) do { vr0 = St::ld8(&Vh[(long)((k0) + sr) * LDK + sc]); vr1 = St::ld8(&Vh[(long)((k0) + 32 + sr) * LDK + sc]); \
    vr2 = St::ld8(&Vh[(long)((k0) + sr) * LDK + 128 + sc]); vr3 = St::ld8(&Vh[(long)((k0) + 32 + sr) * LDK + 128 + sc]); } while (0)
#define KWRITE(b) do { *(bf16x8*)(K_lds + (b) * 16384 + KSWZ(sr, sc * 2)) = kr0; *(bf16x8*)(K_lds + (b) * 16384 + KSWZ(32 + sr, sc * 2)) = kr1; } while (0)
#define VWRITE(b) do { *(bf16x8*)(V_lds + ((b) * 2) * 16384 + vst0) = vr0; *(bf16x8*)(V_lds + ((b) * 2) * 16384 + vst1) = vr1; \
    *(bf16x8*)(V_lds + ((b) * 2 + 1) * 16384 + vst1) = vr2; *(bf16x8*)(V_lds + ((b) * 2 + 1) * 16384 + vst0) = vr3; } while (0)
#define QKH(P, b) do { P = f32x16{}; _Pragma("unroll") for (int d0 = 0; d0 < 8; ++d0) { const int cb = (d0 * 16 + hi * 8) * 2; \
    const bf16x8 kf = *reinterpret_cast<const bf16x8*>(K_lds + (b) * 16384 + KSWZ(32 * kh + r32, cb)); P = __builtin_amdgcn_mfma_f32_32x32x16_bf16(kf, qr[d0], P, 0, 0, 0); } } while (0)
#define PK4(P, BASE, OUT) do { unsigned a0 = cvtpk(P[BASE + 0], P[BASE + 1]), a1 = cvtpk(P[BASE + 2], P[BASE + 3]);   \
    unsigned b0 = cvtpk(P[BASE + 4], P[BASE + 5]), b1 = cvtpk(P[BASE + 6], P[BASE + 7]);                              \
    auto r0 = __builtin_amdgcn_permlane32_swap(a0, b0, false, false); auto r1 = __builtin_amdgcn_permlane32_swap(a1, b1, false, false); \
    u32x4 w = {r0[0], r1[0], r0[1], r1[1]}; OUT = *reinterpret_cast<bf16x8*>(&w); } while (0)
  const int NT = seq / KVBLK;
  f32x16 pc, pn; pn = f32x16{};
  bf16x8 q0 = {}, q1 = {}, q2 = {}, q3 = {};
  char* XC0 = XCH;
  KLOAD(0); VLOAD(0); asm volatile("s_waitcnt vmcnt(0)" ::: "memory"); KWRITE(0); VWRITE(0);
  KLOAD(KVBLK); VLOAD(KVBLK); asm volatile("s_waitcnt vmcnt(0)" ::: "memory"); KWRITE(1); VWRITE(1);
  __syncthreads();
  QKH(pc, 0);
  KLOAD((2 < NT ? 2 : NT - 1) * KVBLK);
  __syncthreads();
  for (int j = 0; j < NT; ++j) {
    const int b = j & 1;
    PvT T;
    pv2_issue<2, 3>(T, vb0 + (b ^ 1) * 32768);
    QKH(pn, b ^ 1);
    float ps = 0.f;
#pragma unroll
    for (int r = 0; r < 16; ++r) { pc[r] = __builtin_amdgcn_exp2f(fmaf(pc[r], C, mC)); ps += pc[r]; }
    l_reg += ps;
    pv2_mma(o[2], o[3], T, q0, q1, q2, q3);
    bf16x8 own0, own1; PK4(pc, 0, own0); PK4(pc, 8, own1);
    *(bf16x8*)(XC0 + b * 16384 + ((wid * 2 + 0) * 64 + lane) * 16) = own0; *(bf16x8*)(XC0 + b * 16384 + ((wid * 2 + 1) * 64 + lane) * 16) = own1;
    KWRITE(b);
    __syncthreads();
    VWRITE(b ^ 1);
    { const int kt = (j + 3 < NT) ? j + 3 : NT - 1, vt = (j + 2 < NT) ? j + 2 : NT - 1; KLOAD(kt * KVBLK); VLOAD(vt * KVBLK); }
    q0 = own0; q1 = own1;
    q2 = *(const bf16x8*)(XC0 + b * 16384 + (((wid ^ 4) * 2 + 0) * 64 + lane) * 16); q3 = *(const bf16x8*)(XC0 + b * 16384 + (((wid ^ 4) * 2 + 1) * 64 + lane) * 16);
    pv2_issue<0, 1>(T, vb0 + b * 32768);
    pv2_mma(o[0], o[1], T, q0, q1, q2, q3);
    pc = pn;
  }
  { PvT T; pv2_issue<2, 3>(T, vb0 + ((NT - 1) & 1) * 32768); pv2_mma(o[2], o[3], T, q0, q1, q2, q3); }
  l_reg += __shfl_xor(l_reg, 32);
  if (hi == 0) LI[kh * 128 + rg * 32 + r32] = l_reg;
  __syncthreads();
  float rli[16];
#pragma unroll
  for (int r = 0; r < 16; ++r) { const int row = rg * 32 + crow(r, hi); rli[r] = __builtin_amdgcn_rcpf(LI[row] + LI[128 + row]); }
  float* Ow = Ob + (long)(rg * 32) * LDO + kh * 128;
#pragma unroll
  for (int r = 0; r < 16; ++r) { const int orow = crow(r, hi);
    for (int d0 = 0; d0 < 4; ++d0) Ow[(long)orow * LDO + d0 * 32 + r32] = o[d0][r] * rli[r]; }
#undef KLOAD
#undef VLOAD
#undef KWRITE
#undef VWRITE
#undef QKH
#undef PK4
}
}
#define XB_TMO      128
#define XB_XCNT(j)  (256  + 64 * (j))
#define XB_XSUB(j)  (1280 + 64 * (j))
#define XB_XGEN(j)  (2304 + 64 * (j))
#define XB_TOP      3328
#define XB_TOPGEN   3392
#define XCD_BAR_WORDS 3456
#define XB_SPIN_CAP (1u << 18)

__device__ __forceinline__ unsigned xb_ld(unsigned* p)              { return __hip_atomic_load(p, __ATOMIC_RELAXED, __HIP_MEMORY_SCOPE_AGENT); }
__device__ __forceinline__ unsigned xb_add(unsigned* p, unsigned v) { return __hip_atomic_fetch_add(p, v, __ATOMIC_RELAXED, __HIP_MEMORY_SCOPE_AGENT); }
__device__ __forceinline__ unsigned xb_xcc_id() { return (unsigned)__builtin_amdgcn_s_getreg((3 << 11) | 20) & 0xFu; }
#define XB_SPIN(cond, bar) do { unsigned _sp = 0; while (cond) { __builtin_amdgcn_s_sleep(1); \
    if ((++_sp & 255u) == 0u) { if (xb_ld(&(bar)[XB_TMO])) break; if (_sp > XB_SPIN_CAP) { atomicAdd(&(bar)[XB_TMO], 1u); break; } } } } while (0)

struct XcdBarrier {
    unsigned* bar; unsigned x;
    volatile LAS unsigned* st;
};

__device__ __forceinline__ XcdBarrier xcd_barrier_post(unsigned* bar, volatile LAS unsigned* st) {
    XcdBarrier b; b.bar = bar; b.x = xb_xcc_id(); b.st = st;
    if (threadIdx.x == 0) (void)xb_add(&bar[XB_XCNT(b.x)], 1u);
    return b;
}
__device__ __forceinline__ void xcd_barrier_complete(unsigned* bar, unsigned x, unsigned& nloc, unsigned& nx) {
    const unsigned G = gridDim.x * gridDim.y * gridDim.z;
    unsigned sum, cnt, mine, sp = 0u;
    for (;;) {
        sum = 0u; cnt = 0u; mine = 0u;
#pragma unroll
        for (unsigned j = 0; j < 16; ++j) { const unsigned c = xb_ld(&bar[XB_XCNT(j)]); sum += c; cnt += (c > 0u) ? 1u : 0u; mine = (j == x) ? c : mine; }
        if (sum == G) break;
        __builtin_amdgcn_s_sleep(1);
        if ((++sp & 255u) == 0u) { if (xb_ld(&bar[XB_TMO])) break; if (sp > XB_SPIN_CAP) { atomicAdd(&bar[XB_TMO], 1u); break; } }
    }
    nloc = mine > 0u ? mine : 1u; nx = cnt > 0u ? cnt : 1u;
}

__device__ __forceinline__ void xcd_barrier(const XcdBarrier& b) {
    asm volatile("s_waitcnt vmcnt(0)" ::: "memory");
    __syncthreads();
    if (threadIdx.x == 0) {
        unsigned* bar = b.bar;
        __builtin_amdgcn_s_waitcnt(0);
        unsigned nloc = b.st[0], nx = b.st[1];
        if (nloc == 0u) { xcd_barrier_complete(bar, b.x, nloc, nx); b.st[0] = nloc; b.st[1] = nx; }
        const unsigned old = xb_add(&bar[XB_XSUB(b.x)], 1u);
        const unsigned gen = old / nloc;
        if (old + 1u == (gen + 1u) * nloc) {
            __builtin_amdgcn_fence(__ATOMIC_RELEASE, "agent");
            asm volatile("s_waitcnt vmcnt(0)" ::: "memory");
            const unsigned og = xb_add(&bar[XB_TOP], 1u);
            const unsigned tg = og / nx;
            if (og + 1u == (tg + 1u) * nx) xb_add(&bar[XB_TOPGEN], 1u);
            else XB_SPIN(xb_ld(&bar[XB_TOPGEN]) == tg, bar);
            __builtin_amdgcn_fence(__ATOMIC_ACQUIRE, "agent");
            xb_add(&bar[XB_XGEN(b.x)], 1u);
            asm volatile("s_waitcnt vmcnt(0)" ::: "memory");
        } else {
            XB_SPIN(xb_ld(&bar[XB_XGEN(b.x)]) == gen, bar);
            __builtin_amdgcn_fence(__ATOMIC_ACQUIRE, "agent");
            asm volatile("s_waitcnt vmcnt(0)" ::: "memory");
        }
    }
    __syncthreads();
}

typedef unsigned short u16;
typedef short s8v __attribute__((ext_vector_type(8)));
typedef float f16v __attribute__((ext_vector_type(16)));
typedef float f4v __attribute__((ext_vector_type(4)));
typedef unsigned u2v __attribute__((ext_vector_type(2)));
constexpr int TL = 8192, TC = 256, TT = TL + TC, DM = 2048, DIN = 8192, PST = 8256;
constexpr int C_AU = 0, C_AV = 512, C_AZ = 1024, C_BQ = 1536, C_BI = 2048, C_BFF = 2560, C_BFB = 3072, C_BZ = 3584, C_CQ = 4096, C_CK = 5120, C_CV = 6144, C_CZ = 7168;
constexpr float EPS = 1e-6f;
constexpr int NCH = 132;
constexpr int CW_KMAX = XCD_BAR_WORDS, CW_SPLIT = CW_KMAX + 64, CW_SPLIT2 = CW_SPLIT + 4 * 17 * 64, CW_TICK = CW_SPLIT2 + 4 * 17 * 64, CW_NCNT = CW_TICK + 16 * 64, CTL_WORDS = CW_NCNT + 4 * 32 * 64;
constexpr size_t WS_WIN = 0, WS_WOUT = WS_WIN + (size_t)4 * 8192 * 2048 * 2, WS_X = WS_WOUT + (size_t)4 * 2048 * 2048 * 2, WS_H = WS_X + (size_t)TT * DM * 4,
                 WS_P = WS_H + (size_t)TT * DM * 2, WS_Y = WS_P + (size_t)TT * PST * 2, WS_AO = WS_Y + (size_t)TT * DM * 2, WS_ST = WS_AO + (size_t)TT * DM * 4,
                 WS_DT = WS_ST + (size_t)2 * NCH * 4 * 16384 * 4, WS_MOD = WS_DT + (size_t)2 * NCH * 4 * 128 * 4, WS_LB = WS_MOD + (size_t)4 * 2 * 6144 * 4,
                 WS_LAM = WS_LB + (size_t)2 * 4 * 512 * 4, WS_CTL = WS_LAM + 256, WS_END = WS_CTL + (size_t)CTL_WORDS * 4;
constexpr int LDS_BYTES = 144 * 1024;
#ifndef PROBE_DUP
#define PROBE_DUP 0
#endif
struct Params { const float* in[18]; float* out; unsigned char* ws; };

__device__ __forceinline__ unsigned f2bf(float f) { unsigned u = __float_as_uint(f); return (u + 0x7fffu + ((u >> 16) & 1u)) >> 16; }
__device__ __forceinline__ unsigned pk2(float lo, float hi) { return f2bf(lo) | (f2bf(hi) << 16); }
__device__ __forceinline__ float bf2f(unsigned h) { return __uint_as_float(h << 16); }
__device__ __forceinline__ float bflo(unsigned w) { return __uint_as_float(w << 16); }
__device__ __forceinline__ float bfhi(unsigned w) { return __uint_as_float(w & 0xffff0000u); }
__device__ __forceinline__ float wave_sum(float v) {
#pragma unroll
    for (int o = 1; o < 64; o <<= 1) v += __shfl_xor(v, o);
    return v;
}
__device__ __forceinline__ int crow(int r, int hi) { return (r & 3) + 8 * (r >> 2) + 4 * hi; }
__device__ __forceinline__ float silu_f(float x) { return x * __builtin_amdgcn_rcpf(1.f + __expf(-x)); }
template <int K> __device__ __forceinline__ void mma32(f16v& acc, const LAS u16* A, int lda, const LAS u16* B, int ldb, int lane) {
    const LAS u16* a = A + (lane & 31) * lda + (lane >> 5) * 8; const LAS u16* b = B + (lane & 31) * ldb + (lane >> 5) * 8;
    s8v av[K / 16], bv[K / 16];
#pragma unroll
    for (int k = 0; k < K / 16; ++k) { av[k] = *(const LAS s8v*)(a + 16 * k); bv[k] = *(const LAS s8v*)(b + 16 * k); }
#pragma unroll
    for (int k = 0; k < K / 16; ++k) acc = __builtin_amdgcn_mfma_f32_32x32x16_bf16(av[k], bv[k], acc, 0, 0, 0);
}
template <int K> __device__ __forceinline__ void mma16(f4v& acc, const LAS u16* A, int lda, const LAS u16* B, int ldb, int lane) {
    const LAS u16* a = A + (lane & 15) * lda + (lane >> 4) * 8; const LAS u16* b = B + (lane & 15) * ldb + (lane >> 4) * 8;
    s8v av[K / 32], bv[K / 32];
#pragma unroll
    for (int k = 0; k < K / 32; ++k) { av[k] = *(const LAS s8v*)(a + 32 * k); bv[k] = *(const LAS s8v*)(b + 32 * k); }
#pragma unroll
    for (int k = 0; k < K / 32; ++k) acc = __builtin_amdgcn_mfma_f32_16x16x32_bf16(av[k], bv[k], acc, 0, 0, 0);
}

__device__ __forceinline__ int win_dest(int n) {
    if (n < C_CQ || n >= C_CV) return n;
    const int j = n & 127, base = n & ~127, a = j >> 6, jj = j & 63, i = jj & 31, half = jj >> 5;
    return base + a * 64 + 2 * i + half;
}
__device__ __forceinline__ void transpose_item(const float* __restrict__ W, int K, int N, u16* __restrict__ WT, LAS float* scr, int item, int lane, bool perm) {
    const int nblk = N / 32, kb = item / nblk, nb = item % nblk, k0 = 64 * kb, n0 = 32 * nb;
    float tv[32];
#pragma unroll
    for (int i = 0; i < 32; ++i) tv[i] = W[(size_t)(k0 + 2 * i + (lane >> 5)) * N + n0 + (lane & 31)];
#pragma unroll
    for (int i = 0; i < 32; ++i) scr[(2 * i + (lane >> 5)) * 33 + (lane & 31)] = tv[i];
    asm volatile("s_waitcnt lgkmcnt(0)" ::: "memory");
    const int c = lane & 7;
#pragma unroll
    for (int j = 0; j < 4; ++j) { const int n = (lane >> 3) + 8 * j; const LAS float* s = scr + (8 * c) * 33 + n;
        uint4 o; o.x = pk2(s[0 * 33], s[1 * 33]); o.y = pk2(s[2 * 33], s[3 * 33]); o.z = pk2(s[4 * 33], s[5 * 33]); o.w = pk2(s[6 * 33], s[7 * 33]);
        const int nd = perm ? win_dest(n0 + n) : (n0 + n);
        *(uint4*)(WT + (size_t)nd * K + k0 + 8 * c) = o; }
    asm volatile("s_waitcnt lgkmcnt(0)" ::: "memory");
}

__device__ __forceinline__ void attn_item(const u16* P, float* AO, const unsigned* kmaxu, int item, char* lds) {
    int hm, qrow0, krow0, seq;
    if (item < 512) { hm = item >> 6; qrow0 = (item & 63) * 128; krow0 = 0; seq = TT; }
    else { hm = (item - 512) >> 1; qrow0 = TL + ((item - 512) & 1) * 128; krow0 = TL; seq = TC; }
    const int h = hm >> 1;
    const att::bf16* Pb = (const att::bf16*)P;
    const att::bf16* Q = Pb + (size_t)qrow0 * PST + C_CQ + hm * 128;
    const att::bf16* K = Pb + (size_t)krow0 * PST + C_CK + hm * 128;
    const att::bf16* V = Pb + (size_t)krow0 * PST + C_CV + h * 256;
    float* O = AO + (size_t)qrow0 * DM + hm * 256;
    const float kmax = sqrtf(__uint_as_float(kmaxu[hm]));
    att::attn_dv256_body(Q, K, V, O, seq, kmax, lds);
}

typedef unsigned u4v __attribute__((ext_vector_type(4)));
struct HgrnT { float bl[16], kk[16]; float r, rtot; };
__device__ __forceinline__ void stage_gates(const uint4 raw, const float4 lb0, const float4 lb1, LAS float* Gs, LAS u16* KKs, int t, int c8) {
    const unsigned w[4] = {raw.x, raw.y, raw.z, raw.w}; const float lb[8] = {lb0.x, lb0.y, lb0.z, lb0.w, lb1.x, lb1.y, lb1.z, lb1.w};
    float g[8], kk[8];
#pragma unroll
    for (int e = 0; e < 8; ++e) { const float a = (e & 1) ? bfhi(w[e >> 1]) : bflo(w[e >> 1]);
        const float sig = __builtin_amdgcn_rcpf(1.f + __expf(-a)); const float f = lb[e] + (1.f - lb[e]) * sig;
        g[e] = fmaxf(__logf(f), -80.f); kk[e] = (1.f - lb[e]) * (1.f - sig); }
    *(LAS f4v*)(Gs + t * 128 + c8) = (f4v){g[0], g[1], g[2], g[3]}; *(LAS f4v*)(Gs + t * 128 + c8 + 4) = (f4v){g[4], g[5], g[6], g[7]};
    *(LAS u4v*)(KKs + t * 128 + c8) = (u4v){pk2(kk[0], kk[1]), pk2(kk[2], kk[3]), pk2(kk[4], kk[5]), pk2(kk[6], kk[7])};
}
__device__ __forceinline__ void hgrn_read(HgrnT& G, const LAS float* Gs, const LAS u16* KKs, int dir, int k, int Is, LAS float* tot) {
    float run = 0.f;
#pragma unroll
    for (int js = 0; js < 16; ++js) { const int t = dir ? 63 - (16 * Is + js) : 16 * Is + js;
        run += Gs[t * 128 + k]; G.bl[js] = run; G.kk[js] = bf2f(KKs[t * 128 + k]); }
    tot[Is * 128 + k] = run;
}
__device__ __forceinline__ void hgrn_prefix(HgrnT& G, int k, int Is, const LAS float* tot) {
    float r = 0.f, rt = 0.f;
#pragma unroll
    for (int i = 0; i < 4; ++i) { const float v = tot[i * 128 + k]; rt += v; if (i < Is) r += v; }
    G.r = r; G.rtot = rt;
}
__device__ __forceinline__ void store_vt(const uint4 w, LAS u16* Vt, int t, int c8) {
    const unsigned ww[4] = {w.x, w.y, w.z, w.w};
#pragma unroll
    for (int e = 0; e < 4; ++e) { Vt[(c8 + 2 * e) * 72 + t] = (u16)(ww[e] & 0xffffu); Vt[(c8 + 2 * e + 1) * 72 + t] = (u16)(ww[e] >> 16); }
}
__device__ __forceinline__ int scan_index(int dir, int rc) { return dir ? (rc < 128 ? 4 + 127 - rc : 3 - (rc - 128)) : (rc < 128 ? 4 + rc : rc - 128); }

__device__ __forceinline__ void hgrn_a_item(const u16* P, const float* LBl0, const float* LBl1, float* ST, float* DT, int rc, int h, LAS unsigned char* L, int tid) {
    const int lane = tid & 63, w = tid >> 6, k = tid & 127, Is = tid >> 7;
    const int R0 = rc < 128 ? 64 * rc : TL + 64 * (rc - 128);
    LAS u16* Vt = (LAS u16*)L; LAS u16* Kd = (LAS u16*)(L + 18432); LAS float* tot = (LAS float*)(L + 36864);
    LAS float* Gs = (LAS float*)(L + 40960); LAS u16* KKs = (LAS u16*)(L + 73728);
    uint4 raf[2], rab[2], rv[2]; float4 lbf[2][2], lbb[2][2];
#pragma unroll
    for (int i = 0; i < 2; ++i) { const int idx = tid + 512 * i, t = idx >> 4, c8 = (idx & 15) * 8; const u16* base = P + (size_t)(R0 + t) * PST + h * 128 + c8;
        raf[i] = *(const uint4*)(base + C_BFF); rab[i] = *(const uint4*)(base + C_BFB); rv[i] = *(const uint4*)(base + C_BI);
        lbf[i][0] = *(const float4*)(LBl0 + h * 128 + c8); lbf[i][1] = *(const float4*)(LBl0 + h * 128 + c8 + 4);
        lbb[i][0] = *(const float4*)(LBl1 + h * 128 + c8); lbb[i][1] = *(const float4*)(LBl1 + h * 128 + c8 + 4); }
#pragma unroll
    for (int i = 0; i < 2; ++i) { const int idx = tid + 512 * i; store_vt(rv[i], Vt, idx >> 4, (idx & 15) * 8); }
    for (int dir = 0; dir < 2; ++dir) {
#pragma unroll
        for (int i = 0; i < 2; ++i) { const int idx = tid + 512 * i; stage_gates(dir ? rab[i] : raf[i], dir ? lbb[i][0] : lbf[i][0], dir ? lbb[i][1] : lbf[i][1], Gs, KKs, idx >> 4, (idx & 15) * 8); }
        __syncthreads();
        HgrnT G; hgrn_read(G, Gs, KKs, dir, k, Is, tot);
        __syncthreads();
        hgrn_prefix(G, k, Is, tot);
        const int n = scan_index(dir, rc);
#pragma unroll
        for (int js = 0; js < 16; ++js) { const int t = dir ? 63 - (16 * Is + js) : 16 * Is + js;
            Kd[k * 72 + t] = (u16)f2bf(G.kk[js] * __expf(G.rtot - G.r - G.bl[js])); }
        if (Is == 0) DT[((size_t)(dir * NCH + n) * 4 + h) * 128 + k] = __expf(G.rtot);
        __syncthreads();
        const int mt = w >> 1;
        float* Ug = ST + ((size_t)(dir * NCH + n) * 4 + h) * 16384;
#pragma unroll
        for (int j = 0; j < 2; ++j) { const int nt = (w & 1) * 2 + j; f16v acc = {};
            mma32<64>(acc, Vt + 32 * mt * 72, 72, Kd + 32 * nt * 72, 72, lane);
#pragma unroll
            for (int r = 0; r < 16; ++r) Ug[(32 * mt + crow(r, lane >> 5)) * 128 + 32 * nt + (lane & 31)] = acc[r]; }
        __syncthreads();
    }
}
__device__ __forceinline__ void hgrn_c_item(const u16* P, const float* LBl0, const float* LBl1, const float* ST, const float* hnw, u16* Y, int rc, int h, LAS unsigned char* L, int tid) {
    const int lane = tid & 63, w = tid >> 6, k = tid & 127, Is = tid >> 7;
    const int R0 = rc < 128 ? 64 * rc : TL + 64 * (rc - 128);
    LAS u16* Qt = (LAS u16*)L; LAS u16* Qh = (LAS u16*)(L + 17408); LAS u16* Kt = (LAS u16*)(L + 34816); LAS u16* Vt = (LAS u16*)(L + 78336);
    LAS u16* Am = (LAS u16*)(L + 96768); LAS u16* Sb = (LAS u16*)(L + 105984); LAS float* tot = (LAS float*)(L + 140800);
    LAS float* Gs = (LAS float*)L; LAS u16* KKs = (LAS u16*)(L + 32768); LAS u16* Qs = (LAS u16*)(L + 49152);
    uint4 raf[2], rab[2], rq[2], rv[2]; float4 lbf[2][2], lbb[2][2]; float4 sreg[8];
#pragma unroll
    for (int i = 0; i < 2; ++i) { const int idx = tid + 512 * i, t = idx >> 4, c8 = (idx & 15) * 8; const u16* base = P + (size_t)(R0 + t) * PST + h * 128 + c8;
        raf[i] = *(const uint4*)(base + C_BFF); rab[i] = *(const uint4*)(base + C_BFB); rq[i] = *(const uint4*)(base + C_BQ); rv[i] = *(const uint4*)(base + C_BI);
        lbf[i][0] = *(const float4*)(LBl0 + h * 128 + c8); lbf[i][1] = *(const float4*)(LBl0 + h * 128 + c8 + 4);
        lbb[i][0] = *(const float4*)(LBl1 + h * 128 + c8); lbb[i][1] = *(const float4*)(LBl1 + h * 128 + c8 + 4); }
    { const float* Sg = ST + ((size_t)(0 * NCH + scan_index(0, rc)) * 4 + h) * 16384;
#pragma unroll
      for (int i = 0; i < 8; ++i) { const int idx = tid + 512 * i; sreg[i] = *(const float4*)(Sg + (idx >> 5) * 128 + (idx & 31) * 4); } }
    const int te = tid >> 3, c0 = (tid & 7) * 16;
    const uint4 z0 = *(const uint4*)(P + (size_t)(R0 + te) * PST + C_BZ + h * 128 + c0), z1 = *(const uint4*)(P + (size_t)(R0 + te) * PST + C_BZ + h * 128 + c0 + 8);
#pragma unroll
    for (int i = 0; i < 2; ++i) { const int idx = tid + 512 * i; store_vt(rv[i], Vt, idx >> 4, (idx & 15) * 8); }
    f16v acc = {};
    const int mt = w >> 2, nt = w & 3;
    for (int dir = 0; dir < 2; ++dir) {
#pragma unroll
        for (int i = 0; i < 8; ++i) { const int idx = tid + 512 * i, v = idx >> 5, k4 = (idx & 31) * 4;
            *(LAS u2v*)(Sb + v * 136 + k4) = (u2v){pk2(sreg[i].x, sreg[i].y), pk2(sreg[i].z, sreg[i].w)}; }
        if (dir == 0) { const float* Sg = ST + ((size_t)(1 * NCH + scan_index(1, rc)) * 4 + h) * 16384;
#pragma unroll
            for (int i = 0; i < 8; ++i) { const int idx = tid + 512 * i; sreg[i] = *(const float4*)(Sg + (idx >> 5) * 128 + (idx & 31) * 4); } }
#pragma unroll
        for (int i = 0; i < 2; ++i) { const int idx = tid + 512 * i, t = idx >> 4, c8 = (idx & 15) * 8;
            stage_gates(dir ? rab[i] : raf[i], dir ? lbb[i][0] : lbf[i][0], dir ? lbb[i][1] : lbf[i][1], Gs, KKs, t, c8);
            *(LAS u4v*)(Qs + t * 128 + c8) = (u4v){rq[i].x, rq[i].y, rq[i].z, rq[i].w}; }
        __syncthreads();
        HgrnT G; hgrn_read(G, Gs, KKs, dir, k, Is, tot);
        float qv[16];
#pragma unroll
        for (int js = 0; js < 16; ++js) { const int t = dir ? 63 - (16 * Is + js) : 16 * Is + js; qv[js] = bf2f(Qs[t * 128 + k]); }
        __syncthreads();
        hgrn_prefix(G, k, Is, tot);
        float rI[4];
        { float run = 0.f;
#pragma unroll
          for (int i = 0; i < 4; ++i) { rI[i] = run - G.r; run += tot[i * 128 + k]; } }
        const float er = __expf(G.r);
#pragma unroll
        for (int js = 0; js < 16; ++js) { const int t = dir ? 63 - (16 * Is + js) : 16 * Is + js;
            const float q = qv[js]; const float e1 = __expf(G.bl[js]);
            Qt[t * 136 + k] = (u16)f2bf(q * e1); Qh[t * 136 + k] = (u16)f2bf(q * e1 * er);
#pragma unroll
            for (int Ip = 0; Ip < 4; ++Ip) if (Ip >= Is) {
                const float ex = fminf(rI[Ip] - G.bl[js], 60.f);
                Kt[(8 * Ip * (Ip + 1) + 16 * Is + (t & 15)) * 136 + k] = (u16)f2bf(G.kk[js] * __expf(ex)); } }
        __syncthreads();
#pragma unroll
        for (int j = 0; j < 2; ++j) { const int id = w * 2 + j, Ir = id >> 2, Js = id & 3; const int It = dir ? 3 - Ir : Ir, Jt = dir ? 3 - Js : Js;
            f4v sc = {0.f, 0.f, 0.f, 0.f};
            if (Js <= Ir) mma16<128>(sc, Qt + 16 * It * 136, 136, Kt + (8 * Ir * (Ir + 1) + 16 * Js) * 136, 136, lane);
#pragma unroll
            for (int i = 0; i < 4; ++i) { const int t = 16 * It + 4 * (lane >> 4) + i, tp = 16 * Jt + (lane & 15);
                float v = sc[i]; if (Js > Ir) v = 0.f; else if (Js == Ir) { if (dir ? (tp < t) : (tp > t)) v = 0.f; }
                Am[t * 72 + tp] = (u16)f2bf(v); } }
        __syncthreads();
        mma32<128>(acc, Qh + 32 * mt * 136, 136, Sb + 32 * nt * 136, 136, lane);
        mma32<64>(acc, Am + 32 * mt * 72, 72, Vt + 32 * nt * 72, 72, lane);
        __syncthreads();
    }
    LAS float* Ob = (LAS float*)L;
#pragma unroll
    for (int r = 0; r < 16; ++r) Ob[(32 * mt + crow(r, lane >> 5)) * 132 + 32 * nt + (lane & 31)] = acc[r];
    __syncthreads();
    { float o[16]; float ss = 0.f;
#pragma unroll
      for (int i = 0; i < 16; ++i) { o[i] = Ob[te * 132 + c0 + i]; ss += o[i] * o[i]; }
      ss += __shfl_xor(ss, 1); ss += __shfl_xor(ss, 2); ss += __shfl_xor(ss, 4);
      const float rs = rsqrtf(ss * (1.f / 128.f) + EPS);
      u16* yp = Y + (size_t)(R0 + te) * DM + 512 + h * 128 + c0;
      const unsigned zz[8] = {z0.x, z0.y, z0.z, z0.w, z1.x, z1.y, z1.z, z1.w};
      unsigned ow[8];
#pragma unroll
      for (int i = 0; i < 8; ++i) { const float y0 = o[2 * i] * rs * hnw[c0 + 2 * i] * bflo(zz[i]), y1 = o[2 * i + 1] * rs * hnw[c0 + 2 * i + 1] * bfhi(zz[i]); ow[i] = pk2(y0, y1); }
      *(uint4*)yp = make_uint4(ow[0], ow[1], ow[2], ow[3]); *(uint4*)(yp + 8) = make_uint4(ow[4], ow[5], ow[6], ow[7]); }
    __syncthreads();
}

__device__ __forceinline__ void gmlp_item(const u16* P, const float* lnw, const float* lnb, const float* wsl  , const float* bsl  , u16* Y, int c, int h, LAS unsigned char* L, int tid) {
    const int lane = tid & 63, w = tid >> 6;
    const int R0 = c < 64 ? 128 * c : TL + 128 * (c - 64);
    LAS u16* Wb = (LAS u16*)L; LAS u16* Vb = (LAS u16*)(L + 34816); LAS float* mean = (LAS float*)(L + 69632); LAS float* rstd = mean + 128;
    float4 wreg[8]; uint4 srow[16], vch[4], uu[4], zz[4];
    { const float* wg = wsl + (size_t)h * 16384;
#pragma unroll
      for (int i = 0; i < 8; ++i) { const int idx = tid + 512 * i; wreg[i] = *(const float4*)(wg + (idx >> 5) * 128 + (idx & 31) * 4); } }
#pragma unroll
    for (int rr = 0; rr < 16; ++rr) srow[rr] = *(const uint4*)(P + (size_t)(R0 + 16 * w + rr) * PST + C_AV + lane * 8);
#pragma unroll
    for (int i = 0; i < 4; ++i) { const int idx = tid + 512 * i; vch[i] = *(const uint4*)(P + (size_t)(R0 + (idx >> 4)) * PST + C_AV + h * 128 + (idx & 15) * 8); }
    const int te = tid >> 2, ce = (tid & 3) * 32;
#pragma unroll
    for (int i = 0; i < 4; ++i) { uu[i] = *(const uint4*)(P + (size_t)(R0 + te) * PST + C_AU + h * 128 + ce + 8 * i); zz[i] = *(const uint4*)(P + (size_t)(R0 + te) * PST + C_AZ + h * 128 + ce + 8 * i); }
#pragma unroll
    for (int rr = 0; rr < 16; ++rr) { const int t = 16 * w + rr; const uint4 wv = srow[rr];
        float x[8] = {bflo(wv.x), bfhi(wv.x), bflo(wv.y), bfhi(wv.y), bflo(wv.z), bfhi(wv.z), bflo(wv.w), bfhi(wv.w)};
        float s = 0.f;
#pragma unroll
        for (int i = 0; i < 8; ++i) s += x[i];
        const float mu = wave_sum(s) * (1.f / 512.f); float s2 = 0.f;
#pragma unroll
        for (int i = 0; i < 8; ++i) { const float d = x[i] - mu; s2 += d * d; }
        const float var = wave_sum(s2) * (1.f / 512.f);
        if (lane == 0) { mean[t] = mu; rstd[t] = rsqrtf(var + EPS); } }
#pragma unroll
    for (int i = 0; i < 8; ++i) { const int idx = tid + 512 * i, t = idx >> 5, s4 = (idx & 31) * 4;
        *(LAS u2v*)(Wb + t * 136 + s4) = (u2v){pk2(wreg[i].x, wreg[i].y), pk2(wreg[i].z, wreg[i].w)}; }
    __syncthreads();
#pragma unroll
    for (int i = 0; i < 4; ++i) { const int idx = tid + 512 * i, s = idx >> 4, d8 = (idx & 15) * 8; const uint4 wv = vch[i];
        const float x[8] = {bflo(wv.x), bfhi(wv.x), bflo(wv.y), bfhi(wv.y), bflo(wv.z), bfhi(wv.z), bflo(wv.w), bfhi(wv.w)};
        const float mu = mean[s], rs = rstd[s];
#pragma unroll
        for (int e = 0; e < 8; ++e) { const int d = h * 128 + d8 + e; Vb[(d8 + e) * 136 + s] = (u16)f2bf((x[e] - mu) * rs * lnw[d] + lnb[d]); } }
    __syncthreads();
    const int mt = w >> 1;
    f16v acc0 = {}, acc1 = {};
    mma32<128>(acc0, Wb + 32 * mt * 136, 136, Vb + 32 * ((w & 1) * 2) * 136, 136, lane);
    mma32<128>(acc1, Wb + 32 * mt * 136, 136, Vb + 32 * ((w & 1) * 2 + 1) * 136, 136, lane);
    __syncthreads();
    LAS float* Ob = (LAS float*)L;
#pragma unroll
    for (int r = 0; r < 16; ++r) { const int t = 32 * mt + crow(r, lane >> 5);
        Ob[t * 132 + 32 * ((w & 1) * 2) + (lane & 31)] = acc0[r]; Ob[t * 132 + 32 * ((w & 1) * 2 + 1) + (lane & 31)] = acc1[r]; }
    __syncthreads();
    { const float bsv = bsl[h * 128 + te]; u16* yp = Y + (size_t)(R0 + te) * DM + h * 128 + ce;
#pragma unroll
      for (int i = 0; i < 4; ++i) { const unsigned uw[4] = {uu[i].x, uu[i].y, uu[i].z, uu[i].w}, zw[4] = {zz[i].x, zz[i].y, zz[i].z, zz[i].w}; unsigned ow[4];
#pragma unroll
          for (int e = 0; e < 4; ++e) { const float s0 = Ob[te * 132 + ce + 8 * i + 2 * e] + bsv, s1 = Ob[te * 132 + ce + 8 * i + 2 * e + 1] + bsv;
              ow[e] = pk2(bflo(uw[e]) * s0 * bflo(zw[e]), bfhi(uw[e]) * s1 * bfhi(zw[e])); }
          *(uint4*)(yp + 8 * i) = make_uint4(ow[0], ow[1], ow[2], ow[3]); } }
    __syncthreads();
}

__device__ __forceinline__ void ctx_out_tile(const u16* Y, const u16* WT, const float* Xcin, float* X, const float* gate_c, int tile, LAS unsigned char* L, int tid) {
    const int lane = tid & 63, w = tid >> 6, mt = w & 1, ks = w >> 1;
    const int r0 = (tile >> 6) * 64, n0 = (tile & 63) * 32;
    f16v acc = {};
    LAS u16* As = (LAS u16*)L; LAS u16* Bs = (LAS u16*)(L + 33792);
    const u16* ag = Y + (size_t)(TL + r0) * DM; const u16* bg = WT + (size_t)n0 * DM;
    uint4 ra[4], rb[2];
#pragma unroll
    for (int i = 0; i < 4; ++i) { const int idx = tid + 512 * i; ra[i] = *(const uint4*)(ag + (size_t)(idx >> 5) * DM + (idx & 31) * 8); }
#pragma unroll
    for (int i = 0; i < 2; ++i) { const int idx = tid + 512 * i; rb[i] = *(const uint4*)(bg + (size_t)(idx >> 5) * DM + (idx & 31) * 8); }
    for (int kc = 0; kc < 8; ++kc) {
#pragma unroll
        for (int i = 0; i < 4; ++i) { const int idx = tid + 512 * i; *(LAS u4v*)(As + (idx >> 5) * 264 + (idx & 31) * 8) = (u4v){ra[i].x, ra[i].y, ra[i].z, ra[i].w}; }
#pragma unroll
        for (int i = 0; i < 2; ++i) { const int idx = tid + 512 * i; *(LAS u4v*)(Bs + (idx >> 5) * 264 + (idx & 31) * 8) = (u4v){rb[i].x, rb[i].y, rb[i].z, rb[i].w}; }
        __syncthreads();
        if (kc < 7) {
#pragma unroll
            for (int i = 0; i < 4; ++i) { const int idx = tid + 512 * i; ra[i] = *(const uint4*)(ag + (size_t)(idx >> 5) * DM + (kc + 1) * 256 + (idx & 31) * 8); }
#pragma unroll
            for (int i = 0; i < 2; ++i) { const int idx = tid + 512 * i; rb[i] = *(const uint4*)(bg + (size_t)(idx >> 5) * DM + (kc + 1) * 256 + (idx & 31) * 8); } }
        mma32<64>(acc, As + 32 * mt * 264 + ks * 64, 264, Bs + ks * 64, 264, lane);
        __syncthreads();
    }
    LAS float* red = (LAS float*)L;
#pragma unroll
    for (int r = 0; r < 16; ++r) red[(w * 16 + r) * 64 + lane] = acc[r];
    __syncthreads();
    if (w < 2) { float xc[16], gc;
        gc = gate_c[n0 + (lane & 31)];
#pragma unroll
        for (int r = 0; r < 16; ++r) xc[r] = Xcin[(size_t)(r0 + 32 * w + crow(r, lane >> 5)) * DM + n0 + (lane & 31)];
        asm volatile("" ::: "memory");
#pragma unroll
        for (int r = 0; r < 16; ++r) { float s = 0.f;
#pragma unroll
            for (int q = 0; q < 4; ++q) s += red[((q * 2 + w) * 16 + r) * 64 + lane];
            const int row = TL + r0 + 32 * w + crow(r, lane >> 5), col = n0 + (lane & 31);
            X[(size_t)row * DM + col] = xc[r] + gc * s; } }
    __syncthreads();
}

__device__ __forceinline__ void split_arrive(unsigned* w  , unsigned xcc, unsigned nloc, int tid) {
    asm volatile("s_waitcnt vmcnt(0)" ::: "memory");
    __syncthreads();
    if (tid == 0) {
        const unsigned old = xb_add(&w[64 * xcc], 1u);
        if (old + 1u == nloc) { __builtin_amdgcn_fence(__ATOMIC_RELEASE, "agent"); asm volatile("s_waitcnt vmcnt(0)" ::: "memory"); (void)xb_add(&w[64 * 16], 1u); }
    }
}
__device__ __forceinline__ void split_wait(unsigned* w, unsigned nx, int tid) {
    if (tid == 0) { unsigned sp = 0; while (xb_ld(&w[64 * 16]) < nx) { __builtin_amdgcn_s_sleep(1); if (++sp > (1u << 22)) break; }
        __builtin_amdgcn_fence(__ATOMIC_ACQUIRE, "agent"); asm volatile("s_waitcnt vmcnt(0)" ::: "memory"); }
    __syncthreads();
}

__device__ __forceinline__ void norm_rows(const float* X, const float* nw, const float* md, u16* H, int row0, int nrows, int wave, int lane) {
    for (int row = row0 + wave; row < row0 + nrows; row += 8) {
        const float4* xr = (const float4*)(X + (size_t)row * DM) + lane; float4 v[8]; float ss = 0.f;
#pragma unroll
        for (int j = 0; j < 8; ++j) { v[j] = xr[64 * j]; ss += v[j].x * v[j].x + v[j].y * v[j].y + v[j].z * v[j].z + v[j].w * v[j].w; }
        const float r = rsqrtf(wave_sum(ss) * (1.f / DM) + EPS);
        uint2* hp = (uint2*)(H + (size_t)row * DM) + lane;
#pragma unroll
        for (int j = 0; j < 8; ++j) { const int col = 4 * (lane + 64 * j); const float4 w4 = *(const float4*)(nw + col), sc = *(const float4*)(md + 2048 + col), sh = *(const float4*)(md + col);
            uint2 o; o.x = pk2(v[j].x * r * w4.x * (1.f + sc.x) + sh.x, v[j].y * r * w4.y * (1.f + sc.y) + sh.y);
            o.y = pk2(v[j].z * r * w4.z * (1.f + sc.z) + sh.z, v[j].w * r * w4.w * (1.f + sc.w) + sh.w); hp[64 * j] = o; } }
}
__device__ __forceinline__ void final_rows(const float* X, const float* fw, float* out, int row0, int nrows, int wave, int lane) {
    for (int row = row0 + wave; row < row0 + nrows; row += 8) {
        const float4* xr = (const float4*)(X + (size_t)row * DM) + lane; float4 v[8]; float ss = 0.f;
#pragma unroll
        for (int j = 0; j < 8; ++j) { v[j] = xr[64 * j]; ss += v[j].x * v[j].x + v[j].y * v[j].y + v[j].z * v[j].z + v[j].w * v[j].w; }
        const float r = rsqrtf(wave_sum(ss) * (1.f / DM) + EPS);
        float4* op = (float4*)(out + (size_t)row * DM) + lane;
#pragma unroll
        for (int j = 0; j < 8; ++j) { const float4 w4 = *(const float4*)(fw + 4 * (lane + 64 * j)); op[64 * j] = make_float4(v[j].x * r * w4.x, v[j].y * r * w4.y, v[j].z * r * w4.z, v[j].w * r * w4.w); } }
}

__global__ void __launch_bounds__(512, 2) mega(Params p) {
    extern __shared__ __attribute__((aligned(16))) unsigned char lds[];
    cg::grid_group grid = cg::this_grid();
    LAS unsigned char* L = (LAS unsigned char*)lds;
    int tid = tidx(), lane = tid & 63, wave = tid >> 6; const int bid = blockIdx.x, G = gridDim.x;
    int gw = bid * 8 + wave; const int ngw = G * 8;
#define RETID() do { tid = tidx(); lane = tid & 63; wave = tid >> 6; gw = bid * 8 + wave; } while (0)
    unsigned char* ws = p.ws;
    volatile LAS unsigned* bst = (volatile LAS unsigned*)(L + LDS_BYTES - 16);
    if (tid < 4) bst[tid] = 0u;
    __syncthreads();
    XcdBarrier xbar = xcd_barrier_post((unsigned*)(ws + WS_CTL), bst);
    if (tid == 0) bst[2] = xb_add((unsigned*)(ws + WS_CTL) + CW_TICK + 64 * xbar.x, 1u);
    __syncthreads();
    const int myslot = (int)bst[2];
#define GSYNC() xcd_barrier(xbar)
    u16* WIN = (u16*)(ws + WS_WIN); u16* WOUT = (u16*)(ws + WS_WOUT); float* X = (float*)(ws + WS_X); u16* H = (u16*)(ws + WS_H);
    u16* P = (u16*)(ws + WS_P); u16* Y = (u16*)(ws + WS_Y); float* AO = (float*)(ws + WS_AO); float* ST = (float*)(ws + WS_ST); float* DT = (float*)(ws + WS_DT);
    float* MOD = (float*)(ws + WS_MOD); float* LB = (float*)(ws + WS_LB); float* LAM = (float*)(ws + WS_LAM);

for (int rep_ = 0; rep_ < (PROBE_DUP == 7 ? 2 : 1); ++rep_) {
    { LAS float* scr = (LAS float*)(L + wave * 8448);
      for (int it = gw; it < 40960; it += ngw) {
          if (it < 32768) { const int l = it >> 13; transpose_item(p.in[7] + (size_t)l * 2048 * 8192, 2048, 8192, WIN + (size_t)l * 8192 * 2048, scr, it & 8191, lane, true); }
          else { const int r = it - 32768, l = r >> 11; transpose_item(p.in[16] + (size_t)l * 2048 * 2048, 2048, 2048, WOUT + (size_t)l * 2048 * 2048, scr, r & 2047, lane, false); } }
      __syncthreads();
      LAS float* red = (LAS float*)L;
      for (int it = bid; it < 768; it += G) { const int l = it / 192, col0 = (it % 192) * 32;
          const int c4 = tid & 7, kp = tid >> 3;
          const float* wp = p.in[4] + (size_t)l * 2048 * 6144 + col0 + c4 * 4;
          float4 a = {0.f, 0.f, 0.f, 0.f}, b = {0.f, 0.f, 0.f, 0.f};
#pragma unroll 16
          for (int kk = 0; kk < 32; ++kk) { const int k = 32 * kp + kk; const float sa = silu_f(p.in[1][k]), sb = silu_f(p.in[3][k]);
              const float4 wv = *(const float4*)(wp + (size_t)k * 6144);
              a.x += sa * wv.x; a.y += sa * wv.y; a.z += sa * wv.z; a.w += sa * wv.w; b.x += sb * wv.x; b.y += sb * wv.y; b.z += sb * wv.z; b.w += sb * wv.w; }
          LAS float* rp = red + (kp * 8 + c4) * 8;
          rp[0] = a.x; rp[1] = a.y; rp[2] = a.z; rp[3] = a.w; rp[4] = b.x; rp[5] = b.y; rp[6] = b.z; rp[7] = b.w;
          __syncthreads();
          if (tid < 64) { const int col = tid & 31, src = tid >> 5; float s = 0.f;
              for (int q = 0; q < 64; ++q) s += red[(q * 8 + (col >> 2)) * 8 + src * 4 + (col & 3)];
              MOD[((size_t)l * 2 + src) * 6144 + col0 + col] = s + p.in[5][(size_t)l * 6144 + col0 + col]; }
          __syncthreads(); }
      if (bid == G - 1) {
          for (int i = tid; i < 1024; i += 512) { const int d = i >> 9, c = i & 511; const float* lbp = p.in[12] + (size_t)d * 4 * 512 + c;
              const float v0 = lbp[0], v1 = lbp[512], v2 = lbp[1024], v3 = lbp[1536]; const float mx = fmaxf(fmaxf(v0, v1), fmaxf(v2, v3));
              const float e0 = __expf(v0 - mx), e1 = __expf(v1 - mx), e2 = __expf(v2 - mx), e3 = __expf(v3 - mx), inv = 1.f / (e0 + e1 + e2 + e3);
              float* o = LB + (size_t)d * 4 * 512 + c; o[0] = 0.f; o[512] = e1 * inv; o[1024] = (e1 + e2) * inv; o[1536] = (e1 + e2 + e3) * inv; }
          if (wave < 4) { const float* lp = p.in[14] + (size_t)wave * 4 * 128;
              const float s1 = wave_sum(lp[lane] * lp[128 + lane] + lp[64 + lane] * lp[128 + 64 + lane]);
              const float s2 = wave_sum(lp[256 + lane] * lp[384 + lane] + lp[256 + 64 + lane] * lp[384 + 64 + lane]);
              const float li = 0.8f - 0.6f * expf(-0.3f * (float)wave);
              if (lane == 0) { LAM[wave] = expf(s1) - expf(s2) + li; LAM[4 + wave] = li; } } }
    }
    grid.sync();


}
    bool fusedN = (G == 256);
    { unsigned* bar_ = (unsigned*)(ws + WS_CTL); int nxc = 0;
      for (int q_ = 0; q_ < 16; ++q_) { const unsigned c_ = xb_ld(&bar_[XB_XCNT(q_)]); if (c_) { ++nxc; if (c_ != 32u || q_ >= 8) fusedN = false; } }
      if (nxc != 8) fusedN = false; }

    if (PROBE_DUP == 8) { for (int q_ = 0; q_ < 20; ++q_) GSYNC(); }
    for (int l = 0; l < 4; ++l) {
        const float* mod = MOD + (size_t)l * 2 * 6144;
if (!fusedN || l == 0)
for (int rep_ = 0; rep_ < (PROBE_DUP == 1 ? 2 : 1); ++rep_) {
        RETID();
        { const float* nw = p.in[6] + (size_t)l * DM;
          for (int row = gw; row < TT; row += ngw) {
              const float4* xr = (const float4*)(l == 0 ? (row < TL ? p.in[0] + (size_t)row * DM : p.in[2] + (size_t)(row - TL) * DM) : X + (size_t)row * DM) + lane; float4 v[8]; float ss = 0.f;
#pragma unroll
              for (int j = 0; j < 8; ++j) { v[j] = xr[64 * j]; ss += v[j].x * v[j].x + v[j].y * v[j].y + v[j].z * v[j].z + v[j].w * v[j].w; }
              const float r = rsqrtf(wave_sum(ss) * (1.f / DM) + EPS);
              const float* md = mod + (row >= TL ? 6144 : 0);
              uint2* hp = (uint2*)(H + (size_t)row * DM) + lane;
#pragma unroll
              for (int j = 0; j < 8; ++j) { const int col = 4 * (lane + 64 * j); const float4 w4 = *(const float4*)(nw + col), sc = *(const float4*)(md + 2048 + col), sh = *(const float4*)(md + col);
                  uint2 o; o.x = pk2(v[j].x * r * w4.x * (1.f + sc.x) + sh.x, v[j].y * r * w4.y * (1.f + sc.y) + sh.y);
                  o.y = pk2(v[j].z * r * w4.z * (1.f + sc.z) + sh.z, v[j].w * r * w4.w * (1.f + sc.w) + sh.w); hp[64 * j] = o; } } }
        GSYNC();

}
        { pg8::Gemm g{H, WIN + (size_t)l * 8192 * 2048, TT, DIN, DM}; pg8::MainOrder S; S.init(TL, DIN, G, bid);
          pg8::EpiProj E{P};
          pg8::gemm_phase<pg8::EpiProj, pg8::MainOrder, true, true>(L, g, S, E); }
        RETID();
        { unsigned* sw_ = (unsigned*)(ws + WS_CTL) + CW_SPLIT + l * 17 * 64;
          split_arrive(sw_, xbar.x, bst[0], tid);
          if (bid < 32) { pg8::Gemm g{H, WIN + (size_t)l * 8192 * 2048, TT, DIN, DM}; pg8::TailOrder S{bid}; pg8::EpiProj E{P};
              pg8::gemm_phase<pg8::EpiProj, pg8::TailOrder, true, true>(L, g, S, E); }
          else { split_wait(sw_, bst[1], tid);
              const float* LB0 = LB + (size_t)l * 512; const float* LB1 = LB + (size_t)(4 + l) * 512;
              for (int it = bid - 32; it < 264 + 528; it += G - 32) { RETID();
                  if (it < 264) gmlp_item(P, p.in[8] + (size_t)l * 512, p.in[9] + (size_t)l * 512, p.in[10] + (size_t)l * 4 * 16384, p.in[11] + (size_t)l * 512, Y, it >> 2, it & 3, L, tid);
                  else { const int r = it - 264; hgrn_a_item(P, LB0, LB1, ST, DT, r >> 2, r & 3, L, tid); } } } }
        GSYNC();
        RETID();
        { float mx = 0.f;
          for (int row = gw; row < TT; row += ngw) { const u16* kp = P + (size_t)row * PST + C_CK + lane * 16;
              const uint4 a = *(const uint4*)kp, b2 = *(const uint4*)(kp + 8); const unsigned ww[8] = {a.x, a.y, a.z, a.w, b2.x, b2.y, b2.z, b2.w}; float ss = 0.f;
#pragma unroll
              for (int e = 0; e < 8; ++e) { const float x0 = bflo(ww[e]), x1 = bfhi(ww[e]); ss += x0 * x0 + x1 * x1; }
              ss += __shfl_xor(ss, 1); ss += __shfl_xor(ss, 2); ss += __shfl_xor(ss, 4); mx = fmaxf(mx, ss); }
          if ((lane & 7) == 0) atomicMax((unsigned*)(ws + WS_CTL) + CW_KMAX + l * 8 + (lane >> 3), __float_as_uint(mx)); }
        for (int gid = bid * 512 + tid; gid < 131072; gid += G * 512) {
            const int k = gid & 127, v = (gid >> 7) & 127, h = (gid >> 14) & 3, dir = gid >> 16;
            float S = 0.f;
            float* sp = ST + ((size_t)(dir * NCH) * 4 + h) * 16384 + v * 128 + k; const float* dp = DT + ((size_t)(dir * NCH) * 4 + h) * 128 + k;
            float u[12], d[12], un[12], dn[12];
#pragma unroll
            for (int j = 0; j < 12; ++j) { u[j] = sp[(size_t)j * 65536]; d[j] = dp[(size_t)j * 512]; }
            for (int b = 0; b < NCH / 12; ++b) { const int n0 = 12 * b;
                if (b + 1 < NCH / 12) {
#pragma unroll
                    for (int j = 0; j < 12; ++j) { un[j] = sp[(size_t)(n0 + 12 + j) * 65536]; dn[j] = dp[(size_t)(n0 + 12 + j) * 512]; } }
#pragma unroll
                for (int j = 0; j < 12; ++j) { sp[(size_t)(n0 + j) * 65536] = S; S = d[j] * S + u[j]; }
#pragma unroll
                for (int j = 0; j < 12; ++j) { u[j] = un[j]; d[j] = dn[j]; } } }
        GSYNC();
for (int rep_ = 0; rep_ < ((PROBE_DUP == 4 || PROBE_DUP == 5) ? 2 : 1); ++rep_) {
        RETID();
        { const float* LB0 = LB + (size_t)l * 512; const float* LB1 = LB + (size_t)(4 + l) * 512;
          const int natt = (l < 3) ? 528 : 512;
          for (int it = bid; it < 528 + ((G >= 32) ? 512 : 528); it += G) { RETID();
              if (it < 528) { if (it < natt && !(PROBE_DUP == 5 && rep_ == 1)) {
                  int item = it;
                  if (it < 512 && G == 256) { const int rnd = it >> 8, wg = it & 255; item = ((wg & 7) << 6) | (rnd * 32 + (wg >> 3)); }
                  attn_item(P, AO, (const unsigned*)(ws + WS_CTL) + CW_KMAX + l * 8, item, (char*)lds); __syncthreads(); } }
              else { const int r = it - 528; hgrn_c_item(P, LB0, LB1, ST, p.in[13] + (size_t)l * 128, Y, r >> 2, r & 3, L, tid); } } }
        GSYNC();

}
for (int rep_ = 0; rep_ < (PROBE_DUP == 6 ? 2 : 1); ++rep_) {
        RETID();
        { const float lam = LAM[l], li1 = 1.f - LAM[4 + l]; const float* sw = p.in[15] + (size_t)l * 256;
          const int nrow = (l < 3) ? TT : TL;
          const bool side = (l < 3) && (G >= 32);
          const int apn = side ? (G - 16) * 8 : ngw;
          if (side && bid >= G - 16) { RETID(); const int r = 512 + (bid - (G - 16)); hgrn_c_item(P, LB + (size_t)l * 512, LB + (size_t)(4 + l) * 512, ST, p.in[13] + (size_t)l * 128, Y, r >> 2, r & 3, L, tid); }
          else
          { const float4 s4 = *(const float4*)(sw + lane * 4); const int vh = lane >> 5, e = (lane & 31) * 4, lim = nrow * 4;
            for (int it0 = gw; it0 < lim; it0 += 4 * apn) {
                float4 o0[4], o1[4]; uint2 zw[4];
#pragma unroll
                for (int q = 0; q < 4; ++q) { const int it = it0 + q * apn; const int itc = it < lim ? it : it0; const int row = itc >> 2, h = itc & 3;
                    o0[q] = *(const float4*)(AO + (size_t)row * DM + (h * 4 + vh) * 128 + e); o1[q] = *(const float4*)(AO + (size_t)row * DM + (h * 4 + 2 + vh) * 128 + e);
                    zw[q] = *(const uint2*)(P + (size_t)row * PST + C_CZ + h * 256 + lane * 4); }
                asm volatile("" ::: "memory");
#pragma unroll
                for (int q = 0; q < 4; ++q) { const int it = it0 + q * apn; const int row = it >> 2, h = it & 3;
                    const float d0 = o0[q].x - lam * o1[q].x, d1 = o0[q].y - lam * o1[q].y, d2 = o0[q].z - lam * o1[q].z, d3 = o0[q].w - lam * o1[q].w;
                    const float rs = rsqrtf(wave_sum(d0 * d0 + d1 * d1 + d2 * d2 + d3 * d3) * (1.f / 256.f) + EPS) * li1;
                    uint2 o; o.x = pk2(d0 * rs * s4.x * bflo(zw[q].x), d1 * rs * s4.y * bfhi(zw[q].x)); o.y = pk2(d2 * rs * s4.z * bflo(zw[q].y), d3 * rs * s4.w * bfhi(zw[q].y));
                    if (it < lim) *(uint2*)(Y + (size_t)row * DM + 1024 + h * 256 + lane * 4) = o; } } } }
        GSYNC();

}
        RETID();
        if (l < 3) { for (int rep_ = 0; rep_ < (PROBE_DUP == 9 ? 3 : 1); ++rep_) for (int tile = bid; tile < 256; tile += G) ctx_out_tile(Y, WOUT + (size_t)l * 2048 * 2048, l == 0 ? p.in[2] : X + (size_t)TL * DM, rep_ == 0 ? X : AO, mod + 6144 + 4096, tile, L, tid); }
        if (fusedN && l < 3) split_arrive((unsigned*)(ws + WS_CTL) + CW_SPLIT2 + l * 17 * 64, xbar.x, bst[0], tid);
        if (fusedN) { const int pm = (int)xbar.x * 4 + (myslot >> 3), pn = myslot & 7;
          pg8::Gemm g{Y, WOUT + (size_t)l * 2048 * 2048, TL, DM, DM}; pg8::PanelOrder S{pm, pn};
          pg8::EpiOut E{X, l == 0 ? p.in[0] : X, mod};
          pg8::gemm_phase<pg8::EpiOut, pg8::PanelOrder, true, true>(L, g, S, E);
          RETID();
          asm volatile("s_waitcnt vmcnt(0)" ::: "memory"); __syncthreads();
          if (tid == 0) { unsigned* c_ = (unsigned*)(ws + WS_CTL) + CW_NCNT + 64 * (l * 32 + pm); (void)xb_add(c_, 1u); unsigned sp = 0;
              while (xb_ld(c_) < 8u) { __builtin_amdgcn_s_sleep(1); if (++sp > (1u << 22)) break; }
              __builtin_amdgcn_fence(__ATOMIC_ACQUIRE, "agent"); asm volatile("s_waitcnt vmcnt(0)" ::: "memory"); }
          __syncthreads();
          if (l < 3) { const float* mod1 = MOD + (size_t)(l + 1) * 2 * 6144; const float* nw1 = p.in[6] + (size_t)(l + 1) * DM;
              norm_rows(X, nw1, mod1, H, pm * 256 + pn * 32, 32, wave, lane);
              if (myslot < 4) { split_wait((unsigned*)(ws + WS_CTL) + CW_SPLIT2 + l * 17 * 64, bst[1], tid); RETID();
                  norm_rows(X, nw1, mod1 + 6144, H, TL + ((int)xbar.x * 4 + myslot) * 8, 8, wave, lane); } }
          else final_rows(X, p.in[17], p.out, pm * 256 + pn * 32, 32, wave, lane); }
        else
        { const int M2 = TL;
          pg8::Gemm g{Y, WOUT + (size_t)l * 2048 * 2048, M2, DM, DM}; pg8::StaticOrder S; S.init(M2, DM, G, bid);
          pg8::EpiOut E{X, l == 0 ? p.in[0] : X, mod};
          pg8::gemm_phase<pg8::EpiOut, pg8::StaticOrder, true, true>(L, g, S, E); }
        GSYNC();
    }
    if (!fusedN) {
    RETID();
    { const float* fw = p.in[17];
      for (int row = gw; row < TL; row += ngw) {
          const float4* xr = (const float4*)(X + (size_t)row * DM) + lane; float4 v[8]; float ss = 0.f;
#pragma unroll
          for (int j = 0; j < 8; ++j) { v[j] = xr[64 * j]; ss += v[j].x * v[j].x + v[j].y * v[j].y + v[j].z * v[j].z + v[j].w * v[j].w; }
          const float r = rsqrtf(wave_sum(ss) * (1.f / DM) + EPS);
          float4* op = (float4*)(p.out + (size_t)row * DM) + lane;
#pragma unroll
          for (int j = 0; j < 8; ++j) { const float4 w4 = *(const float4*)(fw + 4 * (lane + 64 * j)); op[64 * j] = make_float4(v[j].x * r * w4.x, v[j].y * r * w4.y, v[j].z * r * w4.z, v[j].w * r * w4.w); } } }
}
}

extern "C" void kernel_launch(void* const* d_in, const int* in_sizes, int n_in, void* d_out, int out_size, void* d_ws, size_t ws_size, hipStream_t stream) {
    static int grid = 0;
    if (grid == 0) {
        if (n_in != 18 || out_size != TL * DM || ws_size < WS_END) { fprintf(stderr, "kernel_launch: unexpected shapes (n_in %d out %d ws %zu need %zu)\n", n_in, out_size, ws_size, (size_t)WS_END); grid = -1; return; }
        int dev = 0, cus = 0, per_cu = 0;
        (void)hipGetDevice(&dev); (void)hipDeviceGetAttribute(&cus, hipDeviceAttributeMultiprocessorCount, dev);
        if (hipFuncSetAttribute((const void*)mega, hipFuncAttributeMaxDynamicSharedMemorySize, LDS_BYTES) != hipSuccess) { fprintf(stderr, "kernel_launch: hipFuncSetAttribute failed\n"); grid = -1; return; }
        (void)hipOccupancyMaxActiveBlocksPerMultiprocessor(&per_cu, (const void*)mega, 512, LDS_BYTES);
        if (per_cu < 1) per_cu = 1;
        grid = cus * per_cu;
        fprintf(stderr, "kernel_launch: grid %d (cus %d x %d)\n", grid, cus, per_cu);
    }
    if (grid < 0) return;
    if (hipMemsetAsync((char*)d_ws + WS_CTL, 0, (size_t)CTL_WORDS * 4, stream) != hipSuccess) { fprintf(stderr, "kernel_launch: memset failed\n"); return; }
    Params p{};
    for (int i = 0; i < 18; ++i) p.in[i] = (const float*)d_in[i];
    p.out = (float*)d_out; p.ws = (unsigned char*)d_ws;
    void* args[] = {&p};
    hipError_t e = hipLaunchCooperativeKernel((const void*)mega, dim3(grid), dim3(512), args, LDS_BYTES, stream);
    if (e != hipSuccess) fprintf(stderr, "kernel_launch: cooperative launch failed: %s (grid %d)\n", hipGetErrorString(e), grid);
}
```
